# Optimizing an MI355X kernel written in HIP

```python
import math
import jax
import jax.numpy as jnp
from jax import lax
import numpy as np

D_MODEL = 1024
BATCH = 8
SEQ = 2048
DEPTH = 2
DEC_BATCH = 32
DEC_SEQ = 4
PAST_LEN = 16384
PAGE_SIZE = 128

N_EVEN = (DEPTH + 1) // 2
N_ODD = DEPTH // 2

CONV_WIDTH = D_MODEL // 2
CONV_K = 31
MLA_HEADS = 8
Q_LORA = 256
KV_LORA = 128
NOPE_DIM = 64
ROPE_DIM = 32
V_DIM = 64
MLA_WIDTH = MLA_HEADS * V_DIM
MLA_SCALE = (NOPE_DIM + ROPE_DIM) ** -0.5
ROPE_THETA = 10000.0
Q_BLOCK = 128
EVEN_SPLITS = (CONV_WIDTH, 2 * CONV_WIDTH, 3 * CONV_WIDTH, 3 * CONV_WIDTH + Q_LORA,
               3 * CONV_WIDTH + Q_LORA + KV_LORA + ROPE_DIM)
EVEN_IN = 3 * CONV_WIDTH + Q_LORA + KV_LORA + ROPE_DIM + MLA_WIDTH
EVEN_OUT = CONV_WIDTH + MLA_WIDTH
SSM_INNER = 2 * D_MODEL
SSM_HEADDIM = 64
SSM_HEADS = SSM_INNER // SSM_HEADDIM
SSM_GROUPS = 4
SSM_HPG = SSM_HEADS // SSM_GROUPS
SSM_STATE = 128
SSM_CONV = 4
SSM_CHUNK = 128
XBC_DIM = SSM_INNER + 2 * SSM_GROUPS * SSM_STATE
ODD_IN = SSM_INNER + XBC_DIM + SSM_HEADS
MEM_LEN = 256
X_HEADS = 4
X_HEAD_DIM = D_MODEL // X_HEADS
EPS = 1e-6

kernel_name = 'hybrid_conv_mla_ssd_decoder_step'

F32 = jnp.float32


def rmsnorm(x, w):
    xf = x.astype(F32)
    y = xf * lax.rsqrt(jnp.mean(xf * xf, axis=-1, keepdims=True) + EPS)
    return (y * w.astype(F32)).astype(x.dtype)


def layernorm(x, w, b):
    xf = x.astype(F32)
    xc = xf - jnp.mean(xf, axis=-1, keepdims=True)
    var = jnp.mean(xc * xc, axis=-1, keepdims=True)
    return (xc * lax.rsqrt(var + EPS) * w.astype(F32) + b.astype(F32)).astype(x.dtype)


def rope(x, pos):
    half = ROPE_DIM // 2
    inv = ROPE_THETA ** (-jnp.arange(half, dtype=F32) / half)
    ang = pos.astype(F32)[:, None] * inv[None, :]
    ang = ang.reshape(ang.shape[0], *([1] * (x.ndim - 3)), half)
    cos, sin = jnp.cos(ang), jnp.sin(ang)
    x1, x2 = x[..., :half].astype(F32), x[..., half:].astype(F32)
    return jnp.concatenate([x1 * cos - x2 * sin, x1 * sin + x2 * cos], axis=-1).astype(x.dtype)


def causal_dwconv(x_ext, w, b):
    c = x_ext.shape[-1]
    y = lax.conv_general_dilated(x_ext, w[:, None, :].astype(x_ext.dtype), window_strides=(1,),
                                 padding='VALID', dimension_numbers=('NWC', 'WIO', 'NWC'),
                                 feature_group_count=c)
    return y + b.astype(x_ext.dtype)


def mla_attend(q_lat, q_rope, ckv, krope, q_pos, k_pos):
    s = (jnp.einsum('bqhc,bkc->bhqk', q_lat, ckv)
         + jnp.einsum('bqhr,bkr->bhqk', q_rope, krope)).astype(F32) * MLA_SCALE
    s = jnp.where(k_pos[None, None, None, :] <= q_pos[None, None, :, None], s, -jnp.inf)
    p = jax.nn.softmax(s, axis=-1).astype(ckv.dtype)
    return jnp.einsum('bhqk,bkc->bqhc', p, ckv)


def mla_attend_blocked(q_lat, q_rope, ckv, krope, q_pos, k_pos):
    b, t = q_lat.shape[:2]
    if t > Q_BLOCK and t % Q_BLOCK == 0:
        nb = t // Q_BLOCK

        def to_blocks(a):
            return jnp.moveaxis(a.reshape(b, nb, Q_BLOCK, *a.shape[2:]), 1, 0)

        def one(args):
            ql, qr, qp = args
            return mla_attend(ql, qr, ckv, krope, qp, k_pos)

        o = lax.map(one, (to_blocks(q_lat), to_blocks(q_rope), q_pos.reshape(nb, Q_BLOCK)))
        return jnp.moveaxis(o, 0, 1).reshape(b, t, *o.shape[3:])
    return mla_attend(q_lat, q_rope, ckv, krope, q_pos, k_pos)


def even_mixer(h, pos, conv_hist, past_ckv, past_krope, w_in, conv_w, conv_b, ln_w, ln_b,
               q_norm_w, kv_norm_w, w_uq, w_uk, w_uv, w_out):
    b, t, _ = h.shape
    u = h @ w_in
    a_val, a_gate, a_g, c_q, kv, b_g = jnp.split(u, EVEN_SPLITS, axis=-1)
    glu = a_val * jax.nn.sigmoid(a_gate)
    ext = jnp.concatenate([conv_hist, glu], axis=1)
    ya = jax.nn.silu(layernorm(causal_dwconv(ext, conv_w, conv_b), ln_w, ln_b))
    q = jnp.einsum('btr,rhd->bthd', rmsnorm(c_q, q_norm_w), w_uq)
    q_rope = rope(q[..., NOPE_DIM:], pos)
    q_lat = jnp.einsum('bthn,chn->bthc', q[..., :NOPE_DIM], w_uk)
    ckv = rmsnorm(kv[..., :KV_LORA], kv_norm_w)
    krope = rope(kv[..., KV_LORA:], pos)
    if past_ckv is None:
        k_ckv, k_rope, k_pos = ckv, krope, pos
    else:
        k_ckv = jnp.concatenate([past_ckv, ckv], axis=1)
        k_rope = jnp.concatenate([past_krope, krope], axis=1)
        k_pos = jnp.arange(past_ckv.shape[1] + t)
    o_lat = mla_attend_blocked(q_lat, q_rope, k_ckv, k_rope, pos, k_pos)
    yb = jnp.einsum('bthc,chv->bthv', o_lat, w_uv).reshape(b, t, MLA_WIDTH)
    y = jnp.concatenate([ya * jax.nn.silu(a_g), yb * jax.nn.silu(b_g)], axis=-1) @ w_out
    return y, ext[:, -(CONV_K - 1):], ckv, krope


def ssd_chunk(state, xs, dt, a, bm, cm):
    xf, bf, cf = xs.astype(F32), bm.astype(F32), cm.astype(F32)
    q = xs.shape[1]
    cum = jnp.cumsum(dt * a, axis=1)
    seg = cum[:, :, None] - cum[:, None, :]
    causal = jnp.tril(jnp.ones((q, q), dtype=bool))[None, :, :, None, None]
    decay = jnp.exp(jnp.where(causal, seg, -jnp.inf))
    cb = jnp.einsum('btgn,bsgn->btsg', cf, bf)
    w = cb[..., None] * decay * dt[:, None]
    y = jnp.einsum('btsge,bsgep->btgep', w, xf)
    y = y + jnp.einsum('btgn,bgepn->btgep', cf, state) * jnp.exp(cum)[..., None]
    to_end = jnp.exp(cum[:, -1:] - cum) * dt
    new_state = (state * jnp.exp(cum[:, -1])[..., None, None]
                 + jnp.einsum('bsge,bsgn,bsgep->bgepn', to_end, bf, xf))
    return new_state, y


def ssd(xs, dt, a, bm, cm, state):
    b, t = xs.shape[:2]
    if t > SSM_CHUNK and t % SSM_CHUNK == 0:
        nc = t // SSM_CHUNK

        def chunks(v):
            return jnp.moveaxis(v.reshape(b, nc, SSM_CHUNK, *v.shape[2:]), 1, 0)

        def step(s, inp):
            xc, dc, bc, cc = inp
            return ssd_chunk(s, xc, dc, a, bc, cc)

        state, ys = lax.scan(step, state, (chunks(xs), chunks(dt), chunks(bm), chunks(cm)))
        return jnp.moveaxis(ys, 0, 1).reshape(b, t, *ys.shape[3:]), state
    state, y = ssd_chunk(state, xs, dt, a, bm, cm)
    return y, state


def odd_mixer(h, conv_hist, ssm_state, w_in, conv_w, conv_b, dt_bias, a_log, d_skip, norm_w, w_out):
    b, t, _ = h.shape
    u = h @ w_in
    z, xbc, dt_raw = jnp.split(u, [SSM_INNER, SSM_INNER + XBC_DIM], axis=-1)
    ext = jnp.concatenate([conv_hist, xbc], axis=1)
    xbc = jax.nn.silu(causal_dwconv(ext, conv_w, conv_b))
    xs, bm, cm = jnp.split(xbc, [SSM_INNER, SSM_INNER + SSM_GROUPS * SSM_STATE], axis=-1)
    xs = xs.reshape(b, t, SSM_GROUPS, SSM_HPG, SSM_HEADDIM)
    bm = bm.reshape(b, t, SSM_GROUPS, SSM_STATE)
    cm = cm.reshape(b, t, SSM_GROUPS, SSM_STATE)
    dt = jax.nn.softplus(dt_raw.astype(F32) + dt_bias.astype(F32)).reshape(b, t, SSM_GROUPS, SSM_HPG)
    a = -jnp.exp(a_log.astype(F32)).reshape(SSM_GROUPS, SSM_HPG)
    state0 = ssm_state.astype(F32).reshape(b, SSM_GROUPS, SSM_HPG, SSM_HEADDIM, SSM_STATE)
    y, state = ssd(xs, dt, a, bm, cm, state0)
    y = y + d_skip.astype(F32).reshape(SSM_GROUPS, SSM_HPG)[..., None] * xs.astype(F32)
    y = y.reshape(b, t, SSM_INNER).astype(h.dtype) * jax.nn.silu(z)
    y = rmsnorm(y.reshape(b, t, SSM_GROUPS, -1), norm_w.reshape(SSM_GROUPS, -1)).reshape(b, t, SSM_INNER)
    new_state = state.reshape(b, SSM_HEADS, SSM_HEADDIM, SSM_STATE).astype(ssm_state.dtype)
    return y @ w_out, ext[:, -(SSM_CONV - 1):], new_state


def mem_kv(mem, norm_w, w_k, w_v):
    b, m, _ = mem.shape
    mn = rmsnorm(mem, norm_w)
    return ((mn @ w_k).reshape(b, m, X_HEADS, X_HEAD_DIM),
            (mn @ w_v).reshape(b, m, X_HEADS, X_HEAD_DIM))


def cross_attn(h, mk, mv, w_qg, w_o):
    b, t, _ = h.shape
    q, g = jnp.split(h @ w_qg, 2, axis=-1)
    q = q.reshape(b, t, X_HEADS, X_HEAD_DIM)
    s = jnp.einsum('bthd,bmhd->bhtm', q, mk).astype(F32) * (X_HEAD_DIM ** -0.5)
    p = jax.nn.softmax(s, axis=-1).astype(h.dtype)
    o = jnp.einsum('bhtm,bmhd->bthd', p, mv).reshape(b, t, D_MODEL)
    return (o * jax.nn.silu(g)) @ w_o


def setup_inputs(seed: int = 0) -> dict:
    key = jax.random.key(seed)
    ks = iter(jax.random.split(key, 64))

    def normal(shape, scale=1.0):
        return jax.random.normal(next(ks), shape, F32) * scale

    def gain(shape):
        return 1.0 + normal(shape, 0.02)

    n_pages = PAST_LEN // PAGE_SIZE
    n_used = DEC_BATCH * n_pages
    n_pool = (n_used * 5) // 4
    page_table = jax.random.permutation(next(ks), n_pool)[:n_used].reshape(DEC_BATCH, n_pages).astype(jnp.int32)

    dt0 = jnp.exp(jax.random.uniform(next(ks), (N_ODD, SSM_HEADS), F32, math.log(1e-3), math.log(1e-1)))
    dt_bias = dt0 + jnp.log(-jnp.expm1(-dt0))
    a_log = jnp.log(jax.random.uniform(next(ks), (N_ODD, SSM_HEADS), F32, 1.0, 16.0))

    return {
        'x_prompt': normal((BATCH, SEQ, D_MODEL)),
        'x_sample': normal((DEC_BATCH, DEC_SEQ, D_MODEL)),
        'mem_prompt': normal((BATCH, MEM_LEN, D_MODEL)),
        'cache_ckv': normal((n_pool, PAGE_SIZE, N_EVEN, KV_LORA)),
        'cache_krope': normal((n_pool, PAGE_SIZE, N_EVEN, ROPE_DIM)),
        'page_table': page_table,
        'state_conv_a': normal((N_EVEN, DEC_BATCH, CONV_K - 1, CONV_WIDTH), 0.5),
        'state_conv_c': normal((N_ODD, DEC_BATCH, SSM_CONV - 1, XBC_DIM)),
        'state_ssm': normal((N_ODD, DEC_BATCH, SSM_HEADS, SSM_HEADDIM, SSM_STATE), 0.3),
        'cache_mem_k': normal((DEPTH, DEC_BATCH, MEM_LEN, X_HEADS, X_HEAD_DIM)),
        'cache_mem_v': normal((DEPTH, DEC_BATCH, MEM_LEN, X_HEADS, X_HEAD_DIM)),
        'norm_pre_mix': gain((DEPTH, D_MODEL)),
        'norm_post_mix': gain((DEPTH, D_MODEL)),
        'norm_pre_x': gain((DEPTH, D_MODEL)),
        'norm_post_x': gain((DEPTH, D_MODEL)),
        'norm_mem': gain((DEPTH, D_MODEL)),
        'x_w_qg': normal((DEPTH, D_MODEL, 2 * D_MODEL), D_MODEL ** -0.5),
        'x_w_k': normal((DEPTH, D_MODEL, D_MODEL), D_MODEL ** -0.5),
        'x_w_v': normal((DEPTH, D_MODEL, D_MODEL), D_MODEL ** -0.5),
        'x_w_o': normal((DEPTH, D_MODEL, D_MODEL), D_MODEL ** -0.5),
        'e_w_in': normal((N_EVEN, D_MODEL, EVEN_IN), D_MODEL ** -0.5),
        'e_conv_w': normal((N_EVEN, CONV_K, CONV_WIDTH), CONV_K ** -0.5),
        'e_conv_b': normal((N_EVEN, CONV_WIDTH), 0.02),
        'e_ln_w': gain((N_EVEN, CONV_WIDTH)),
        'e_ln_b': normal((N_EVEN, CONV_WIDTH), 0.02),
        'e_q_norm': gain((N_EVEN, Q_LORA)),
        'e_kv_norm': gain((N_EVEN, KV_LORA)),
        'e_w_uq': normal((N_EVEN, Q_LORA, MLA_HEADS, NOPE_DIM + ROPE_DIM), Q_LORA ** -0.5),
        'e_w_uk': normal((N_EVEN, KV_LORA, MLA_HEADS, NOPE_DIM), KV_LORA ** -0.5),
        'e_w_uv': normal((N_EVEN, KV_LORA, MLA_HEADS, V_DIM), KV_LORA ** -0.5),
        'e_w_out': normal((N_EVEN, EVEN_OUT, D_MODEL), EVEN_OUT ** -0.5),
        'o_w_in': normal((N_ODD, D_MODEL, ODD_IN), D_MODEL ** -0.5),
        'o_conv_w': normal((N_ODD, SSM_CONV, XBC_DIM), SSM_CONV ** -0.5),
        'o_conv_b': normal((N_ODD, XBC_DIM), 0.02),
        'o_dt_bias': dt_bias,
        'o_a_log': a_log,
        'o_d': gain((N_ODD, SSM_HEADS)),
        'o_norm': gain((N_ODD, SSM_INNER)),
        'o_w_out': normal((N_ODD, SSM_INNER, D_MODEL), SSM_INNER ** -0.5),
    }


def reference(x_prompt, x_sample, mem_prompt, cache_ckv, cache_krope, page_table, state_conv_a,
              state_conv_c, state_ssm, cache_mem_k, cache_mem_v, norm_pre_mix, norm_post_mix,
              norm_pre_x, norm_post_x, norm_mem, x_w_qg, x_w_k, x_w_v, x_w_o, e_w_in, e_conv_w,
              e_conv_b, e_ln_w, e_ln_b, e_q_norm, e_kv_norm, e_w_uq, e_w_uk, e_w_uv, e_w_out,
              o_w_in, o_conv_w, o_conv_b, o_dt_bias, o_a_log, o_d, o_norm, o_w_out):
    bp, sp, _ = x_prompt.shape
    bs, ss, _ = x_sample.shape
    past_len = page_table.shape[1] * cache_ckv.shape[1]
    pos_p = jnp.arange(sp)
    pos_s = past_len + jnp.arange(ss)
    xp, xs = x_prompt, x_sample
    ckv_p, ckv_s, kr_p, kr_s, ca_p, ca_s = [], [], [], [], [], []
    cc_p, cc_s, ssm_p, ssm_s, mk_p, mv_p = [], [], [], [], [], []
    for i in range(DEPTH):
        hp = rmsnorm(xp, norm_pre_mix[i])
        hs = rmsnorm(xs, norm_pre_mix[i])
        if i % 2 == 0:
            l = i // 2
            ep = (e_w_in[l], e_conv_w[l], e_conv_b[l], e_ln_w[l], e_ln_b[l], e_q_norm[l],
                  e_kv_norm[l], e_w_uq[l], e_w_uk[l], e_w_uv[l], e_w_out[l])
            yp, a_new, c_new, r_new = even_mixer(
                hp, pos_p, jnp.zeros((bp, CONV_K - 1, CONV_WIDTH), xp.dtype), None, None, *ep)
            ca_p.append(a_new); ckv_p.append(c_new); kr_p.append(r_new)
            past_ckv = cache_ckv[page_table, :, l].reshape(bs, past_len, KV_LORA)
            past_kr = cache_krope[page_table, :, l].reshape(bs, past_len, ROPE_DIM)
            ys, a_new, c_new, r_new = even_mixer(hs, pos_s, state_conv_a[l], past_ckv, past_kr, *ep)
            ca_s.append(a_new); ckv_s.append(c_new); kr_s.append(r_new)
        else:
            l = i // 2
            op = (o_w_in[l], o_conv_w[l], o_conv_b[l], o_dt_bias[l], o_a_log[l], o_d[l],
                  o_norm[l], o_w_out[l])
            yp, c_new, s_new = odd_mixer(
                hp, jnp.zeros((bp, SSM_CONV - 1, XBC_DIM), xp.dtype),
                jnp.zeros((bp, SSM_HEADS, SSM_HEADDIM, SSM_STATE), xp.dtype), *op)
            cc_p.append(c_new); ssm_p.append(s_new)
            ys, c_new, s_new = odd_mixer(hs, state_conv_c[l], state_ssm[l], *op)
            cc_s.append(c_new); ssm_s.append(s_new)
        xp = xp + rmsnorm(yp, norm_post_mix[i])
        xs = xs + rmsnorm(ys, norm_post_mix[i])
        mk, mv = mem_kv(mem_prompt, norm_mem[i], x_w_k[i], x_w_v[i])
        mk_p.append(mk); mv_p.append(mv)
        xp = xp + rmsnorm(cross_attn(rmsnorm(xp, norm_pre_x[i]), mk, mv, x_w_qg[i], x_w_o[i]), norm_post_x[i])
        xs = xs + rmsnorm(cross_attn(rmsnorm(xs, norm_pre_x[i]), cache_mem_k[i], cache_mem_v[i],
                                     x_w_qg[i], x_w_o[i]), norm_post_x[i])
    return (xp, xs,
            jnp.stack(ckv_p, axis=2), jnp.stack(ckv_s, axis=2),
            jnp.stack(kr_p, axis=2), jnp.stack(kr_s, axis=2),
            jnp.stack(ca_p), jnp.stack(ca_s),
            jnp.stack(cc_p), jnp.stack(cc_s),
            jnp.stack(ssm_p), jnp.stack(ssm_s),
            jnp.stack(mk_p), jnp.stack(mv_p))
```

```cpp
#include <hip/hip_runtime.h>
#include <cstdio>
#include <cstdint>
namespace pg8 {
#define PG8_LAS __attribute__((address_space(3)))
typedef unsigned short bf16_t;
typedef short bf16x8 __attribute__((ext_vector_type(8)));
typedef float f32x4 __attribute__((ext_vector_type(4)));
typedef unsigned u32x4 __attribute__((ext_vector_type(4)));
constexpr int BM = 256, BK = 64, HALF = 128, HTB = HALF * BK * 2  , STAGE_BYTES = 8 * HTB, NXCD = 8, WGM = 8;

__host__ __device__ __forceinline__ int lds_byte(int r, int c) { const int st = (r >> 4) * 2 + (c >> 5), rr = r & 15, cc = c & 31, ob = rr * 64 + cc * 2; return st * 1024 + (ob ^ (((ob >> 9) & 1) << 5)); }
__host__ __device__ __forceinline__ void stage_rc(int b, int& R, int& C) { const int st = b / 1024, sb = b % 1024, swz = sb ^ (((sb >> 9) & 1) << 5); R = (st >> 1) * 16 + swz / 64; C = (st & 1) * 32 + (swz % 64) / 2; }
__host__ __device__ __forceinline__ int perm32(int rho) { const int n = rho >> 4, i = rho & 15; return 8 * (i >> 2) + 4 * n + (i & 3); }

struct Unit { int pm, pn; };
struct Gemm { const bf16_t* A; const bf16_t* Bt; int M, N, K; };

struct StaticOrder {
    int nM, nN, nwg, G, c;
    __host__ __device__ void init(int M, int N, int G_, int c_) { nM = M / BM; nN = N / BM; nwg = nM * nN; G = G_; c = c_; }
    __host__ __device__ bool next(int i, Unit& u) const {
        const long L = (long)i * G + c; if (L >= nwg) return false;
        int wgid = (int)L; { const int q = nwg / NXCD, r = nwg % NXCD, xcd = wgid % NXCD, off = wgid / NXCD; wgid = (xcd < r ? xcd * (q + 1) : r * (q + 1) + (xcd - r) * q) + off; }
        const int nig = WGM * nN, gid = wgid / nig, fm = gid * WGM, gsz = (nM - fm) < WGM ? (nM - fm) : WGM;
        u.pm = fm + ((wgid % nig) % gsz); u.pn = (wgid % nig) / gsz; return true;
    }
    __device__ __forceinline__ void a_ready(const Unit&) const {}
    __device__ __forceinline__ void done(const Unit&) const {}
};
template <class Epi, class Sched, bool ALIGN_EPI = false, bool SP2 = false>
__device__ __forceinline__ void gemm_phase(PG8_LAS unsigned char* lds, const Gemm g, const Sched& S, const Epi& E, const int tid_in) {
    const int tid = tid_in, wid = __builtin_amdgcn_readfirstlane(tid >> 6), lane = tid & 63, wr = wid >> 2, wc = wid & 3, fr = lane & 15, fq = lane >> 4;
    const int K = g.K, nt = K / BK;
    unsigned voffA[2], voffB[2];
#pragma unroll
    for (int i = 0; i < 2; ++i) { int R, C; stage_rc(tid * 16 + i * 8192, R, C); const int Rb = Epi::PERM ? ((R & ~31) + perm32(R & 31)) : R;
        voffA[i] = (unsigned)(R * K + C) * 2u; voffB[i] = (unsigned)(Rb * K + C) * 2u; }
    const size_t kstep = (size_t)(BK * 2);
    const size_t hstep = (size_t)HALF * K * 2;
    const size_t tstep = 2 * hstep;
    const unsigned ldsw = (unsigned)wid * 1024u;
    const int aoff = lds_byte(wr * 64 + fr, fq * 8), boff = lds_byte(wc * 32 + fr, fq * 8);
#define PG8_SA(b, h) (((b) * 2 + (h)) * HTB)
#define PG8_SB(b, h) ((4 + (b) * 2 + (h)) * HTB)
#define PG8_STAGE(bufoff, gbase, voff) do { _Pragma("unroll") for (int _i = 0; _i < 2; ++_i) \
        __builtin_amdgcn_global_load_lds((const unsigned*)((const char*)(gbase) + (voff)[_i]), (PG8_LAS unsigned*)(lds + (bufoff) + ldsw + _i * 8192), 16, 0, 0); } while (0)
#define PG8_LDA(dst, b, h) do { _Pragma("unroll") for (int m = 0; m < 4; ++m) _Pragma("unroll") for (int k = 0; k < 2; ++k) dst[m][k] = *(const PG8_LAS bf16x8*)(lds + PG8_SA(b, h) + aoff + m * 2048 + k * 1024); } while (0)
#define PG8_LDB(dst, b, h) do { _Pragma("unroll") for (int n = 0; n < 2; ++n) _Pragma("unroll") for (int k = 0; k < 2; ++k) dst[n][k] = *(const PG8_LAS bf16x8*)(lds + PG8_SB(b, h) + boff + n * 2048 + k * 1024); } while (0)
#define PG8_MMA(ai, bj, At, Bt) do { __builtin_amdgcn_s_setprio(1); _Pragma("unroll") for (int m = 0; m < 4; ++m) _Pragma("unroll") for (int n = 0; n < 2; ++n) _Pragma("unroll") for (int k = 0; k < 2; ++k) \
        acc[ai][bj][m][n] = __builtin_amdgcn_mfma_f32_16x16x32_bf16(Bt[n][k], At[m][k], acc[ai][bj][m][n], 0, 0, 0); __builtin_amdgcn_s_setprio(0); } while (0)
#define PG8_WAIT_V(n) asm volatile("s_waitcnt vmcnt(" #n ")" ::: "memory")
#define PG8_WAIT_L(n) asm volatile("s_waitcnt lgkmcnt(" #n ")" ::: "memory")
#define PG8_BAR __builtin_amdgcn_s_barrier()
#define PG8_SCHED __builtin_amdgcn_sched_barrier(0)
    Unit cur, nxt; int ui = 0;
    if (!S.next(0, cur)) return;
    f32x4 acc[2][2][4][2];
#pragma unroll
    for (int a = 0; a < 2; ++a)
#pragma unroll
        for (int b = 0; b < 2; ++b)
#pragma unroll
            for (int m = 0; m < 4; ++m)
#pragma unroll
                for (int n = 0; n < 2; ++n) acc[a][b][m][n] = (f32x4){0.f, 0.f, 0.f, 0.f};
    bf16x8 At[4][2], B0[2][2], B1[2][2];
    const char* cA = (const char*)g.A + (size_t)cur.pm * tstep; const char* cB = (const char*)g.Bt + (size_t)cur.pn * tstep;
    S.a_ready(cur);
    if constexpr (SP2) {
        PG8_STAGE(PG8_SB(0, 0), cB, voffB); PG8_STAGE(PG8_SB(0, 1), cB + hstep, voffB); PG8_STAGE(PG8_SA(0, 0), cA, voffA); PG8_STAGE(PG8_SA(0, 1), cA + hstep, voffA);
        if (wr == 1) PG8_BAR;
        PG8_WAIT_V(2); PG8_BAR;
        PG8_STAGE(PG8_SB(1, 0), cB + kstep, voffB); PG8_STAGE(PG8_SA(1, 0), cA + kstep, voffA); PG8_STAGE(PG8_SB(1, 1), cB + hstep + kstep, voffB);
        PG8_WAIT_V(6); PG8_BAR;
    } else {
        PG8_STAGE(PG8_SB(0, 0), cB, voffB); PG8_STAGE(PG8_SA(0, 0), cA, voffA); PG8_STAGE(PG8_SB(0, 1), cB + hstep, voffB); PG8_STAGE(PG8_SA(0, 1), cA + hstep, voffA);
        if (wr == 1) PG8_BAR;
        PG8_WAIT_V(4); PG8_BAR;
        PG8_STAGE(PG8_SB(1, 0), cB + kstep, voffB); PG8_STAGE(PG8_SA(1, 0), cA + kstep, voffA); PG8_STAGE(PG8_SB(1, 1), cB + hstep + kstep, voffB);
        PG8_WAIT_V(6); PG8_BAR;
    }
    for (;;) {
        const bool has_next = S.next(ui + 1, nxt);
        const char* nA = has_next ? (const char*)g.A + (size_t)nxt.pm * tstep : cA; const char* nB = has_next ? (const char*)g.Bt + (size_t)nxt.pn * tstep : cB;
        for (int t = 0; t < nt; t += 2) {
            const bool last = (t == nt - 2);
            const char* a1 = cA + (size_t)(t + 1) * kstep;
            const char* a2 = last ? nA : cA + (size_t)(t + 2) * kstep; const char* b2 = last ? nB : cB + (size_t)(t + 2) * kstep;
            const char* a3 = a2 + kstep; const char* b3 = b2 + kstep;
            if (last && has_next) S.a_ready(nxt);
            if constexpr (SP2) {
            PG8_LDB(B0, 0, 0); PG8_LDB(B1, 0, 1); PG8_SCHED; PG8_LDA(At, 0, 0); PG8_STAGE(PG8_SA(1, 1), a1 + hstep, voffA);
            PG8_WAIT_V(8); PG8_WAIT_L(0); PG8_BAR; PG8_MMA(0, 0, At, B0); PG8_MMA(0, 1, At, B1); PG8_BAR; PG8_SCHED;
            PG8_LDA(At, 0, 1); PG8_STAGE(PG8_SB(0, 0), b2, voffB); PG8_STAGE(PG8_SB(0, 1), b2 + hstep, voffB); PG8_STAGE(PG8_SA(0, 0), a2, voffA);
            PG8_WAIT_V(8); PG8_WAIT_L(0); PG8_BAR; PG8_MMA(1, 0, At, B0); PG8_MMA(1, 1, At, B1); PG8_BAR; PG8_SCHED;
            PG8_LDB(B0, 1, 0); PG8_LDB(B1, 1, 1); PG8_SCHED; PG8_LDA(At, 1, 0); PG8_STAGE(PG8_SA(0, 1), a2 + hstep, voffA);
            PG8_WAIT_V(8); PG8_WAIT_L(0); PG8_BAR; PG8_MMA(0, 0, At, B0); PG8_MMA(0, 1, At, B1); PG8_BAR; PG8_SCHED;
            PG8_LDA(At, 1, 1); PG8_STAGE(PG8_SB(1, 0), b3, voffB); PG8_STAGE(PG8_SB(1, 1), b3 + hstep, voffB); PG8_STAGE(PG8_SA(1, 0), a3, voffA);
            PG8_WAIT_V(8); PG8_WAIT_L(0); PG8_BAR; PG8_MMA(1, 0, At, B0); PG8_MMA(1, 1, At, B1); PG8_BAR; PG8_SCHED;
            } else {
            PG8_LDB(B0, 0, 0); PG8_SCHED; PG8_LDA(At, 0, 0); PG8_STAGE(PG8_SA(1, 1), a1 + hstep, voffA);
            PG8_WAIT_L(8); PG8_BAR; PG8_WAIT_L(0); PG8_MMA(0, 0, At, B0); PG8_BAR; PG8_SCHED;
            PG8_LDB(B1, 0, 1); PG8_STAGE(PG8_SB(0, 0), b2, voffB);
            PG8_BAR; PG8_WAIT_L(0); PG8_MMA(0, 1, At, B1); PG8_BAR;
            PG8_LDA(At, 0, 1); PG8_STAGE(PG8_SA(0, 0), a2, voffA);
            PG8_BAR; PG8_WAIT_L(0); PG8_MMA(1, 0, At, B0); PG8_BAR; PG8_SCHED;
            PG8_STAGE(PG8_SB(0, 1), b2 + hstep, voffB);
            PG8_WAIT_V(6); PG8_BAR; PG8_MMA(1, 1, At, B1); PG8_BAR;
            PG8_LDB(B0, 1, 0); PG8_SCHED; PG8_LDA(At, 1, 0); PG8_STAGE(PG8_SA(0, 1), a2 + hstep, voffA);
            PG8_WAIT_L(8); PG8_BAR; PG8_WAIT_L(0); PG8_MMA(0, 0, At, B0); PG8_BAR; PG8_SCHED;
            PG8_LDB(B1, 1, 1); PG8_STAGE(PG8_SB(1, 0), b3, voffB);
            PG8_BAR; PG8_WAIT_L(0); PG8_MMA(0, 1, At, B1); PG8_BAR;
            PG8_LDA(At, 1, 1); PG8_STAGE(PG8_SA(1, 0), a3, voffA);
            PG8_BAR; PG8_WAIT_L(0); PG8_MMA(1, 0, At, B0); PG8_BAR; PG8_SCHED;
            PG8_STAGE(PG8_SB(1, 1), b3 + hstep, voffB);
            PG8_WAIT_V(6); PG8_BAR; PG8_MMA(1, 1, At, B1); PG8_BAR;
            }
        }
        if constexpr (ALIGN_EPI) { if (wr == 0) PG8_BAR; }
        if constexpr (!Epi::AFTER_DRAIN) { E(acc, cur, wr, wc, fr, fq); S.done(cur); }
        if (!has_next) break;
#pragma unroll
        for (int a = 0; a < 2; ++a)
#pragma unroll
            for (int b = 0; b < 2; ++b)
#pragma unroll
                for (int m = 0; m < 4; ++m)
#pragma unroll
                    for (int n = 0; n < 2; ++n) acc[a][b][m][n] = (f32x4){0.f, 0.f, 0.f, 0.f};
        cur = nxt; cA = nA; cB = nB; ++ui;
        if constexpr (ALIGN_EPI) { if (wr == 1) PG8_BAR; }
    }
    PG8_WAIT_V(0);
    if constexpr (!ALIGN_EPI) { if (wr == 0) PG8_BAR; }
    PG8_BAR;
    if constexpr (Epi::AFTER_DRAIN) { E.fused(acc, cur, wr, wc, fr, fq, lds, wid, lane); S.done(cur); }
#undef PG8_SA
#undef PG8_SB
#undef PG8_STAGE
#undef PG8_LDA
#undef PG8_LDB
#undef PG8_MMA
#undef PG8_WAIT_V
#undef PG8_WAIT_L
#undef PG8_BAR
#undef PG8_SCHED
}
}
#define GAS __attribute__((address_space(1)))
#define LAS __attribute__((address_space(3)))
typedef unsigned short bf16;
typedef short bf16x8 __attribute__((ext_vector_type(8)));
typedef short s16x4 __attribute__((ext_vector_type(4)));
typedef float f32x4 __attribute__((ext_vector_type(4)));
typedef float f32x2 __attribute__((ext_vector_type(2)));
typedef float f32x16 __attribute__((ext_vector_type(16)));
typedef unsigned u32x4 __attribute__((ext_vector_type(4)));
typedef unsigned u32x2 __attribute__((ext_vector_type(2)));
typedef GAS unsigned gu32;
#define RLX_AGENT __ATOMIC_RELAXED, __HIP_MEMORY_SCOPE_AGENT
#define LDS_WAIT() asm volatile("s_waitcnt lgkmcnt(0)" ::: "memory")
__device__ __forceinline__ f32x4 ldnt4(const float* p) { return __builtin_nontemporal_load((const f32x4*)p); }
#define PRIO_HI() __builtin_amdgcn_s_setprio(1)
#define PRIO_LO() __builtin_amdgcn_s_setprio(0)
#define SCHED_FENCE() __builtin_amdgcn_sched_barrier(0)
#define VM_WAIT() asm volatile("s_waitcnt vmcnt(0)" ::: "memory")

typedef __bf16 bf16x2_t __attribute__((ext_vector_type(2)));
__device__ __forceinline__ unsigned pk2(float lo, float hi) { const f32x2 v = {lo, hi}; const bf16x2_t b = __builtin_convertvector(v, bf16x2_t); return __builtin_bit_cast(unsigned, b); }
__device__ __forceinline__ unsigned f2bf(float f) { return pk2(f, 0.f) & 0xffffu; }
__device__ __forceinline__ float bf2f(unsigned h) { return __builtin_bit_cast(float, h << 16); }
__device__ __forceinline__ float bflo(unsigned w) { return __builtin_bit_cast(float, w << 16); }
__device__ __forceinline__ float bfhi(unsigned w) { return __builtin_bit_cast(float, w & 0xffff0000u); }
template <int CTRL> __device__ __forceinline__ float dpp_mov(float v) { return __builtin_bit_cast(float, __builtin_amdgcn_update_dpp(0, __builtin_bit_cast(int, v), CTRL, 0xF, 0xF, false)); }
__device__ __forceinline__ float wave_sum(float v) {
    v += dpp_mov<0xB1>(v); v += dpp_mov<0x4E>(v); v += dpp_mov<0x124>(v); v += dpp_mov<0x128>(v);
    const int b = __builtin_bit_cast(int, v);
    const float s0 = __builtin_bit_cast(float, __builtin_amdgcn_readlane(b, 0)), s1 = __builtin_bit_cast(float, __builtin_amdgcn_readlane(b, 16));
    const float s2 = __builtin_bit_cast(float, __builtin_amdgcn_readlane(b, 32)), s3 = __builtin_bit_cast(float, __builtin_amdgcn_readlane(b, 48));
    return (s0 + s1) + (s2 + s3);
}
__device__ __forceinline__ float xhalf(float v) { const unsigned u = __builtin_bit_cast(unsigned, v); const auto r = __builtin_amdgcn_permlane32_swap(u, u, false, false);
    const int hi = (int)(__builtin_amdgcn_mbcnt_hi(~0u, __builtin_amdgcn_mbcnt_lo(~0u, 0u)) >> 5); return __builtin_bit_cast(float, hi ? r[0] : r[1]); }
__device__ __forceinline__ float sigmoidf_(float x) { return __builtin_amdgcn_rcpf(1.f + __expf(-x)); }
__device__ __forceinline__ float siluf_(float x) { return x * __builtin_amdgcn_rcpf(1.f + __expf(-x)); }
__device__ __forceinline__ float max3f(float a, float b, float c) { float r; asm("v_max3_f32 %0, %1, %2, %3" : "=v"(r) : "v"(a), "v"(b), "v"(c)); return r; }
__device__ __forceinline__ float max2f(float a, float b) { float r; asm("v_max_f32_e32 %0, %1, %2" : "=v"(r) : "v"(a), "v"(b)); return r; }
__device__ __forceinline__ int crow(int r, int hi) { return (r & 3) + 8 * (r >> 2) + 4 * hi; }
__device__ __forceinline__ f32x16 mfma32(bf16x8 a, bf16x8 b, f32x16 c) { return __builtin_amdgcn_mfma_f32_32x32x16_bf16(a, b, c, 0, 0, 0); }
typedef short v4i16_t __attribute__((ext_vector_type(4)));
__device__ __forceinline__ s16x4 tr_read(const LAS unsigned char* p) { return __builtin_bit_cast(s16x4, __builtin_amdgcn_ds_read_tr16_b64_v4i16((LAS v4i16_t*)p)); }
__device__ __forceinline__ bf16x8 cat4(s16x4 lo, s16x4 hi) { return (bf16x8){lo[0], lo[1], lo[2], lo[3], hi[0], hi[1], hi[2], hi[3]}; }
__device__ __forceinline__ bf16x8 pack8(float a0, float a1, float a2, float a3, float a4, float a5, float a6, float a7) {
    u32x4 w; w.x = pk2(a0, a1); w.y = pk2(a2, a3); w.z = pk2(a4, a5); w.w = pk2(a6, a7); return __builtin_bit_cast(bf16x8, w);
}

constexpr int DM = 1024, MP = 16384, MS = 128, MT = MP + MS, MR = 16640, TP = 2048, NBP = 8, NBS = 32, TS = 4;
constexpr float EPS = 1e-6f;
constexpr float LOG2E = 1.4426950408889634f;
constexpr float C_MLA = 0.10206207261596575f * LOG2E;
constexpr float C_X = 0.0625f * LOG2E;

constexpr size_t O_Y = 0, O_YS = O_Y + (size_t)MP * DM, O_CKVP = O_YS + (size_t)MS * DM, O_CKVS = O_CKVP + (size_t)MP * 128, O_KRP = O_CKVS + (size_t)MS * 128,
    O_KRS = O_KRP + (size_t)MP * 32, O_CAP = O_KRS + (size_t)MS * 32, O_CAS = O_CAP + (size_t)8 * 30 * 512, O_CCP = O_CAS + (size_t)32 * 30 * 512,
    O_CCS = O_CCP + (size_t)8 * 3 * 3072, O_SSMP = O_CCS + (size_t)32 * 3 * 3072, O_SSMS = O_SSMP + (size_t)8 * 32 * 64 * 128, O_MK = O_SSMS + (size_t)32 * 32 * 64 * 128,
    O_MV = O_MK + (size_t)2 * 2048 * 1024, O_END = O_MV + (size_t)2 * 2048 * 1024;

constexpr size_t al256(size_t x) { return (x + 255) & ~(size_t)255; }
constexpr size_t WS_CTL = 0, CTL_BYTES = 1u << 20;
constexpr size_t WS_WEIN = CTL_BYTES;
constexpr size_t WS_WMKV = WS_WEIN + (size_t)2560 * 1024 * 2;
constexpr size_t WS_WQ = WS_WMKV + (size_t)2 * 2048 * 1024 * 2;
constexpr size_t WS_WUVT = WS_WQ + (size_t)1280 * 256 * 2;
constexpr size_t WS_WEOUT = WS_WUVT + (size_t)8 * 64 * 128 * 2;
constexpr size_t WS_WQG = WS_WEOUT + (size_t)1024 * 1024 * 2;
constexpr size_t WS_WXO = WS_WQG + (size_t)2 * 2048 * 1024 * 2;
constexpr size_t WS_WOIN = WS_WXO + (size_t)2 * 1024 * 1024 * 2;
constexpr size_t WS_WDT = WS_WOIN + (size_t)5120 * 1024 * 2;
constexpr size_t WS_WOOUT = WS_WDT + (size_t)32 * 1024 * 2;
constexpr size_t WS_ROPE = WS_WOOUT + (size_t)1024 * 2048 * 2;
constexpr size_t WS_H = al256(WS_ROPE + (size_t)2052 * 32 * 4);
constexpr size_t WS_MN = WS_H + (size_t)MR * 1024 * 2;
constexpr size_t WS_GLU = WS_MN + (size_t)2 * 2048 * 1024 * 2;
constexpr size_t WS_GATE = WS_GLU + (size_t)MR * 512 * 2;
constexpr size_t WS_CQ = WS_GATE + (size_t)MR * 1024 * 2;
constexpr size_t WS_CQN = WS_CQ + (size_t)MR * 256 * 2;
constexpr size_t WS_KVRAW = WS_CQN + (size_t)MR * 256 * 2;
constexpr size_t WS_KP = WS_KVRAW + (size_t)MR * 256 * 2;
constexpr size_t WS_QP = WS_KP + (size_t)MR * 160 * 2;
constexpr size_t WS_YCAT = WS_QP + (size_t)MR * 1280 * 2;
constexpr size_t WS_YB = WS_YCAT + (size_t)MR * 1024 * 2;
constexpr size_t WS_XQ = WS_YB + (size_t)MR * 1024 * 2;
constexpr size_t WS_XG = WS_XQ + (size_t)MR * 1024 * 2;
constexpr size_t WS_XO = WS_XG + (size_t)MR * 1024 * 2;
constexpr size_t WS_MKV = WS_XO + (size_t)MR * 1024 * 2;
constexpr size_t WS_ZS = WS_MKV + (size_t)4 * 2048 * 1024 * 2;
constexpr size_t WS_XBC = WS_ZS + (size_t)MR * 2048 * 2;
constexpr size_t WS_XBCC = WS_XBC + (size_t)MR * 3072 * 2;
constexpr size_t WS_DT = WS_XBCC + (size_t)MR * 3072 * 2;
constexpr size_t WS_YZ = WS_DT + (size_t)MR * 32 * 4;
constexpr size_t WS_YN = WS_YZ + (size_t)MR * 2048 * 2;
constexpr size_t PART_STRIDE = 4096 + 64;
constexpr size_t WS_PART = WS_YN + (size_t)MR * 2048 * 2;
constexpr size_t WS_XR = WS_PART + (size_t)32 * 64 * PART_STRIDE * 4;
constexpr size_t WS_END = WS_XR + (size_t)MR * 1024 * 2;

constexpr int LDS_BYTES = 147456, RING_BYTES = 131072, MISC_OFF = LDS_BYTES - 256;
constexpr int CW_BAR = 4096;
#define XB_TMO      128
#define XB_XCNT(j)  (256  + 64 * (j))
#define XB_XSUB(j)  (1280 + 64 * (j))
#define XB_XGEN(j)  (2304 + 64 * (j))
#define XB_TOP      3328
#define XB_TOPGEN   3392
#define XCD_BAR_WORDS 3456
#define XB_SPIN_CAP (1u << 18)

__device__ __forceinline__ unsigned xb_ld(unsigned* p)              { return __hip_atomic_load(p, __ATOMIC_RELAXED, __HIP_MEMORY_SCOPE_AGENT); }
__device__ __forceinline__ unsigned xb_add(unsigned* p, unsigned v) { return __hip_atomic_fetch_add(p, v, __ATOMIC_RELAXED, __HIP_MEMORY_SCOPE_AGENT); }
__device__ __forceinline__ unsigned xb_xcc_id() { return (unsigned)__builtin_amdgcn_s_getreg((3 << 11) | 20) & 0xFu; }
#define XB_SPIN(cond, bar) do { unsigned _sp = 0; while (cond) { __builtin_amdgcn_s_sleep(1); \
    if ((++_sp & 255u) == 0u) { if (xb_ld(&(bar)[XB_TMO])) break; if (_sp > XB_SPIN_CAP) { atomicAdd(&(bar)[XB_TMO], 1u); break; } } } } while (0)

struct XcdBarrier {
    unsigned* bar; unsigned x;
    volatile LAS unsigned* st;
};

__device__ __forceinline__ XcdBarrier xcd_barrier_post(unsigned* bar, volatile LAS unsigned* st, int tid) {
    XcdBarrier b; b.bar = bar; b.x = xb_xcc_id(); b.st = st;
    if (tid == 0) (void)xb_add(&bar[XB_XCNT(b.x)], 1u);
    return b;
}
__device__ __forceinline__ void xcd_barrier_complete(unsigned* bar, unsigned x, unsigned& nloc, unsigned& nx) {
    const unsigned G = gridDim.x * gridDim.y * gridDim.z;
    unsigned sum, cnt, mine, sp = 0u;
    for (;;) {
        sum = 0u; cnt = 0u; mine = 0u;
#pragma unroll
        for (unsigned j = 0; j < 16; ++j) { const unsigned c = xb_ld(&bar[XB_XCNT(j)]); sum += c; cnt += (c > 0u) ? 1u : 0u; mine = (j == x) ? c : mine; }
        if (sum == G) break;
        __builtin_amdgcn_s_sleep(1);
        if ((++sp & 255u) == 0u) { if (xb_ld(&bar[XB_TMO])) break; if (sp > XB_SPIN_CAP) { atomicAdd(&bar[XB_TMO], 1u); break; } }
    }
    nloc = mine > 0u ? mine : 1u; nx = cnt > 0u ? cnt : 1u;
}

__device__ __forceinline__ void xcd_barrier(const XcdBarrier& b, int tid) {
    asm volatile("s_waitcnt vmcnt(0)" ::: "memory");
    __syncthreads();
    if (tid == 0) {
        unsigned* bar = b.bar;
        __builtin_amdgcn_s_waitcnt(0);
        unsigned nloc = b.st[0], nx = b.st[1];
        if (nloc == 0u) { xcd_barrier_complete(bar, b.x, nloc, nx); b.st[0] = nloc; b.st[1] = nx; }
        const unsigned old = xb_add(&bar[XB_XSUB(b.x)], 1u);
        const unsigned gen = old / nloc;
        if (old + 1u == (gen + 1u) * nloc) {
            __builtin_amdgcn_fence(__ATOMIC_RELEASE, "agent");
            asm volatile("s_waitcnt vmcnt(0)" ::: "memory");
            const unsigned og = xb_add(&bar[XB_TOP], 1u);
            const unsigned tg = og / nx;
            if (og + 1u == (tg + 1u) * nx) xb_add(&bar[XB_TOPGEN], 1u);
            else XB_SPIN(xb_ld(&bar[XB_TOPGEN]) == tg, bar);
            __builtin_amdgcn_fence(__ATOMIC_ACQUIRE, "agent");
            xb_add(&bar[XB_XGEN(b.x)], 1u);
            asm volatile("s_waitcnt vmcnt(0)" ::: "memory");
        } else {
            XB_SPIN(xb_ld(&bar[XB_XGEN(b.x)]) == gen, bar);
            __builtin_amdgcn_fence(__ATOMIC_ACQUIRE, "agent");
            asm volatile("s_waitcnt vmcnt(0)" ::: "memory");
        }
    }
    __syncthreads();
}
struct Params { const float* in[39]; float* out; unsigned char* ws; int ph_lo, ph_hi; };
struct Ctx { LAS unsigned char* lds; int tid, lane, wave, G, cu, gw, NGW; };

#define IN_XP 0
#define IN_XS 1
#define IN_MEM 2
#define IN_CCKV 3
#define IN_CKR 4
#define IN_PT 5
#define IN_SCA 6
#define IN_SCC 7
#define IN_SSM 8
#define IN_CMK 9
#define IN_CMV 10
#define IN_NPM 11
#define IN_NQM 12
#define IN_NPX 13
#define IN_NQX 14
#define IN_NMEM 15
#define IN_XWQG 16
#define IN_XWK 17
#define IN_XWV 18
#define IN_XWO 19
#define IN_EWIN 20
#define IN_ECW 21
#define IN_ECB 22
#define IN_ELNW 23
#define IN_ELNB 24
#define IN_EQN 25
#define IN_EKVN 26
#define IN_EWUQ 27
#define IN_EWUK 28
#define IN_EWUV 29
#define IN_EWOUT 30
#define IN_OWIN 31
#define IN_OCW 32
#define IN_OCB 33
#define IN_ODTB 34
#define IN_OALOG 35
#define IN_OD 36
#define IN_ONORM 37
#define IN_OWOUT 38

template <int W> __device__ __forceinline__ void store_bf(bf16* dst, const float (&v)[W]) {
    if constexpr (W == 8) { u32x4 w; w.x = pk2(v[0], v[1]); w.y = pk2(v[2], v[3]); w.z = pk2(v[4], v[5]); w.w = pk2(v[6], v[7]); *(u32x4*)dst = w; }
    else if constexpr (W == 4) { u32x2 w; w.x = pk2(v[0], v[1]); w.y = pk2(v[2], v[3]); *(u32x2*)dst = w; }
    else { static_assert(W == 2, "W"); *(unsigned*)dst = pk2(v[0], v[1]); }
}

template <class F> struct Epi8 {
    static constexpr bool PERM = true, AFTER_DRAIN = false;
    F f;
    __device__ __forceinline__ void operator()(const pg8::f32x4 (&acc)[2][2][4][2], const pg8::Unit& u, int wr, int wc, int fr, int fq) const {
        const int row0 = u.pm * 256 + wr * 64 + fr, col0 = u.pn * 256 + wc * 32 + 8 * fq;
#pragma unroll
        for (int ai = 0; ai < 2; ++ai)
#pragma unroll
            for (int m = 0; m < 4; ++m)
#pragma unroll
                for (int bj = 0; bj < 2; ++bj) {
                    const float v[8] = {acc[ai][bj][m][0][0], acc[ai][bj][m][0][1], acc[ai][bj][m][0][2], acc[ai][bj][m][0][3],
                                        acc[ai][bj][m][1][0], acc[ai][bj][m][1][1], acc[ai][bj][m][1][2], acc[ai][bj][m][1][3]};
                    f.template operator()<8>(row0 + ai * 128 + m * 16, col0 + bj * 128, v);
                }
    }
};

template <class F>
__device__ __forceinline__ void skinny_unit(const Ctx& c, const bf16* A, int lda, const bf16* Bt, int ldb, int K, int rowT0, int colT0, int rowT1, int colT1, const F& f) {
    const int lane = c.lane, r32 = lane & 31, hi = lane >> 5, w = c.wave, tile = w & 1, ks = w >> 1;
    const int row0 = tile ? rowT1 : rowT0, col0 = tile ? colT1 : colT0, Ks = K >> 2;
    const bf16* ap = A + (size_t)(row0 + r32) * lda + ks * Ks + 8 * hi;
    const bf16* bp = Bt + (size_t)(col0 + r32) * ldb + ks * Ks + 8 * hi;
    f32x16 acc = {};
#pragma unroll 2
    for (int k = 0; k < Ks; k += 64) {
        const bf16x8 a0 = *(const bf16x8*)(ap + k), a1 = *(const bf16x8*)(ap + k + 16), a2 = *(const bf16x8*)(ap + k + 32), a3 = *(const bf16x8*)(ap + k + 48);
        const bf16x8 b0 = *(const bf16x8*)(bp + k), b1 = *(const bf16x8*)(bp + k + 16), b2 = *(const bf16x8*)(bp + k + 32), b3 = *(const bf16x8*)(bp + k + 48);
        acc = mfma32(b0, a0, acc); acc = mfma32(b1, a1, acc); acc = mfma32(b2, a2, acc); acc = mfma32(b3, a3, acc);
    }
    LAS float* P = (LAS float*)c.lds;
#pragma unroll
    for (int r = 0; r < 16; ++r) P[(w * 16 + r) * 64 + lane] = acc[r];
    __syncthreads();
    {
        const int g = w >> 1; float v[4];
#pragma unroll
        for (int i = 0; i < 4; ++i) { const int r = 4 * g + i; v[i] = (P[((tile + 0) * 16 + r) * 64 + lane] + P[((tile + 2) * 16 + r) * 64 + lane]) + (P[((tile + 4) * 16 + r) * 64 + lane] + P[((tile + 6) * 16 + r) * 64 + lane]); }
        f.template operator()<4>(row0 + r32, col0 + 8 * g + 4 * hi, v);
    }
    __syncthreads();
}
template <class F>
__device__ __forceinline__ void skinny_sample(const Ctx& c, const bf16* A, int lda, const bf16* Bt, int ldb, int K, int ncols, const F& f, int cu_rot) {
    const int vc = (c.cu + c.G - cu_rot % c.G) % c.G;
    for (int u = vc; u < (ncols / 64) * 4; u += c.G) { const bf16* Au = A; asm volatile("" : "+s"(Au));
        const int rb = u & 3, cp = u >> 2; skinny_unit(c, Au, lda, Bt, ldb, K, MP + 32 * rb, 64 * cp, MP + 32 * rb, 64 * cp + 32, f); }
}

struct FGemm1 {
    bf16 *GLU, *GATE, *CQ, *KVRAW;
    template <int W> __device__ __forceinline__ void operator()(int row, int col, const float (&v)[W]) const {
        if (col < 1024) { float o[W / 2];
#pragma unroll
            for (int i = 0; i < W / 2; ++i) o[i] = v[2 * i] * sigmoidf_(v[2 * i + 1]);
            store_bf<W / 2>(GLU + (size_t)row * 512 + (col >> 1), o); }
        else if (col < 1536) { float o[W];
#pragma unroll
            for (int i = 0; i < W; ++i) o[i] = siluf_(v[i]);
            store_bf<W>(GATE + (size_t)row * 1024 + (col - 1024), o); }
        else if (col < 1792) store_bf<W>(CQ + (size_t)row * 256 + (col - 1536), v);
        else if (col < 2304) { float o[W];
#pragma unroll
            for (int i = 0; i < W; ++i) o[i] = siluf_(v[i]);
            store_bf<W>(GATE + (size_t)row * 1024 + 512 + (col - 1792), o); }
        else store_bf<W>(KVRAW + (size_t)row * 256 + (col - 2304), v);
    }
};
struct FMemKV {
    float *OK, *OV; bf16 *BK, *BV;
    template <int W> __device__ __forceinline__ void operator()(int row, int col, const float (&v)[W]) const {
        float* o = (col < 1024) ? OK + (size_t)row * 1024 + col : OV + (size_t)row * 1024 + (col - 1024);
        bf16* b = (col < 1024) ? BK + (size_t)row * 1024 + col : BV + (size_t)row * 1024 + (col - 1024);
#pragma unroll
        for (int i = 0; i < W; i += 4) *(f32x4*)(o + i) = (f32x4){v[i], v[i + 1], v[i + 2], v[i + 3]};
        store_bf<W>(b, v);
    }
};
__device__ __forceinline__ int pos_index(int row) { return row < MP ? (row & (TP - 1)) : TP + ((row - MP) & 3); }
struct FQ {
    bf16* QP; const float* ROPE;
    template <int W> __device__ __forceinline__ void operator()(int row, int col, const float (&v)[W]) const {
        float o[W];
        if (col < 1024) {
#pragma unroll
            for (int i = 0; i < W; ++i) o[i] = v[i] * C_MLA;
        } else { const float* rp = ROPE + ((size_t)pos_index(row) * 16 + (((col - 1024) & 31) >> 1)) * 2;
#pragma unroll
            for (int i = 0; i < W / 2; ++i) { const float cs = rp[2 * i], sn = rp[2 * i + 1], x1 = v[2 * i] * C_MLA, x2 = v[2 * i + 1] * C_MLA; o[2 * i] = x1 * cs - x2 * sn; o[2 * i + 1] = x1 * sn + x2 * cs; }
        }
        store_bf<W>(QP + (size_t)row * 1280 + col, o);
    }
};
struct FPlain { bf16* O; int ldo;
    template <int W> __device__ __forceinline__ void operator()(int row, int col, const float (&v)[W]) const { store_bf<W>(O + (size_t)row * ldo + col, v); }
};
struct FQG {
    bf16 *XQ, *XG;
    template <int W> __device__ __forceinline__ void operator()(int row, int col, const float (&v)[W]) const {
        float o[W];
        if (col < 1024) {
#pragma unroll
            for (int i = 0; i < W; ++i) o[i] = v[i] * C_X;
            store_bf<W>(XQ + (size_t)row * 1024 + col, o);
        } else {
#pragma unroll
            for (int i = 0; i < W; ++i) o[i] = siluf_(v[i]);
            store_bf<W>(XG + (size_t)row * 1024 + (col - 1024), o);
        }
    }
};
struct FOIn {
    bf16 *ZS, *XBC;
    template <int W> __device__ __forceinline__ void operator()(int row, int col, const float (&v)[W]) const {
        if (col < 2048) { float o[W];
#pragma unroll
            for (int i = 0; i < W; ++i) o[i] = siluf_(v[i]);
            store_bf<W>(ZS + (size_t)row * 2048 + col, o); }
        else store_bf<W>(XBC + (size_t)row * 3072 + (col - 2048), v);
    }
};
struct FDt {
    float* DT; const float* bias;
    template <int W> __device__ __forceinline__ void operator()(int row, int col, const float (&v)[W]) const {
#pragma unroll
        for (int i = 0; i < W; ++i) { const float x = v[i] + bias[col + i]; DT[(size_t)row * 32 + col + i] = x > 20.f ? x : log1pf(__expf(x)); }
    }
};
__device__ __forceinline__ int ein_src_col(int n) {
    if (n < 1024) return (n & 1) ? 512 + (n >> 1) : (n >> 1);
    if (n < 1792) return n;
    if (n < 2304) return 1952 + (n - 1792);
    if (n < 2464) return 1792 + (n - 2304);
    return -1;
}
__device__ __forceinline__ void transpose_item(const float* W, int K, int N, bf16* WT, int drows, int kind, int coff, int item, LAS float* scr, int lane) {
    const int nblk = drows / 32, kb = item / nblk, nb = item % nblk, k0 = 64 * kb, n0 = 32 * nb;
    const int nd = n0 + (lane & 31);
    const int sn = kind == 1 ? ein_src_col(nd) : nd + coff;
#pragma unroll 8
    for (int i = 0; i < 32; ++i) { const int kk = 2 * i + (lane >> 5); scr[kk * 33 + (lane & 31)] = sn >= 0 ? W[(size_t)(k0 + kk) * N + sn] : 0.f; }
    LDS_WAIT(); asm volatile("" ::: "memory");
    const int c = lane & 7;
#pragma unroll
    for (int j = 0; j < 4; ++j) { const int n = (lane >> 3) + 8 * j; const LAS float* s = scr + (8 * c) * 33 + n;
        u32x4 o; o.x = pk2(s[0 * 33], s[1 * 33]); o.y = pk2(s[2 * 33], s[3 * 33]); o.z = pk2(s[4 * 33], s[5 * 33]); o.w = pk2(s[6 * 33], s[7 * 33]);
        *(u32x4*)(WT + (size_t)(n0 + n) * K + k0 + 8 * c) = o; }
    LDS_WAIT(); asm volatile("" ::: "memory");
}
__device__ __forceinline__ void rms_row_to_bf16(const float* xrow, const float* w, bf16* orow, int lane) {
    const f32x4* xr = (const f32x4*)xrow + lane; const f32x4* wr = (const f32x4*)w + lane;
    f32x4 v[4]; float s = 0.f;
#pragma unroll
    for (int j = 0; j < 4; ++j) { v[j] = xr[64 * j]; s += (v[j].x * v[j].x + v[j].y * v[j].y) + (v[j].z * v[j].z + v[j].w * v[j].w); }
    const float r = rsqrtf(wave_sum(s) * (1.f / 1024.f) + EPS);
    u32x2* o8 = (u32x2*)orow + lane;
#pragma unroll
    for (int j = 0; j < 4; ++j) { const f32x4 ww = wr[64 * j]; u32x2 o; o.x = pk2(v[j].x * r * ww.x, v[j].y * r * ww.y); o.y = pk2(v[j].z * r * ww.z, v[j].w * r * ww.w); o8[64 * j] = o; }
}
template <bool IN32, bool OUT32>
__device__ __forceinline__ void resid_row(const void* xi, const bf16* y, const float* wpost, void* xo, const float* wpre, bf16* h, int lane) {
    const u32x2* yr = (const u32x2*)y + lane; const f32x4* wq = (const f32x4*)wpost + lane;
    f32x4 yv[4]; float s = 0.f;
#pragma unroll
    for (int j = 0; j < 4; ++j) { const u32x2 t = yr[64 * j]; yv[j] = (f32x4){bflo(t.x), bfhi(t.x), bflo(t.y), bfhi(t.y)}; s += (yv[j].x * yv[j].x + yv[j].y * yv[j].y) + (yv[j].z * yv[j].z + yv[j].w * yv[j].w); }
    f32x4 xv[4];
#pragma unroll
    for (int j = 0; j < 4; ++j) { if constexpr (IN32) xv[j] = ((const f32x4*)xi + lane)[64 * j]; else { const u32x2 t = ((const u32x2*)xi + lane)[64 * j]; xv[j] = (f32x4){bflo(t.x), bfhi(t.x), bflo(t.y), bfhi(t.y)}; } }
    const float r = rsqrtf(wave_sum(s) * (1.f / 1024.f) + EPS);
    float s2 = 0.f;
#pragma unroll
    for (int j = 0; j < 4; ++j) { const f32x4 ww = wq[64 * j]; xv[j] = xv[j] + yv[j] * r * ww; s2 += (xv[j].x * xv[j].x + xv[j].y * xv[j].y) + (xv[j].z * xv[j].z + xv[j].w * xv[j].w); }
#pragma unroll
    for (int j = 0; j < 4; ++j) { if constexpr (OUT32) ((f32x4*)xo + lane)[64 * j] = xv[j]; else { u32x2 o; o.x = pk2(xv[j].x, xv[j].y); o.y = pk2(xv[j].z, xv[j].w); ((u32x2*)xo + lane)[64 * j] = o; } }
    if (wpre) {
        const float r2 = rsqrtf(wave_sum(s2) * (1.f / 1024.f) + EPS);
        const f32x4* wp = (const f32x4*)wpre + lane; u32x2* o8 = (u32x2*)h + lane;
#pragma unroll
        for (int j = 0; j < 4; ++j) { const f32x4 ww = wp[64 * j]; u32x2 o; o.x = pk2(xv[j].x * r2 * ww.x, xv[j].y * r2 * ww.y); o.y = pk2(xv[j].z * r2 * ww.z, xv[j].w * r2 * ww.w); o8[64 * j] = o; }
    }
}
template <int MODE>
__device__ __forceinline__ void phase_resid(const Params& p, const Ctx& c, const float* wpost, const float* wpre) {
    unsigned char* ws = p.ws; const bf16* YB = (const bf16*)(ws + WS_YB); bf16* H = (bf16*)(ws + WS_H); bf16* XR = (bf16*)(ws + WS_XR);
    for (int r = c.gw; r < MT; r += c.NGW) {
        if constexpr (MODE == 0) resid_row<true, false>(r < MP ? p.in[IN_XP] + (size_t)r * DM : p.in[IN_XS] + (size_t)(r - MP) * DM, YB + (size_t)r * DM, wpost, XR + (size_t)r * DM, wpre, H + (size_t)r * DM, c.lane);
        else if constexpr (MODE == 1) resid_row<false, false>(XR + (size_t)r * DM, YB + (size_t)r * DM, wpost, XR + (size_t)r * DM, wpre, H + (size_t)r * DM, c.lane);
        else resid_row<false, true>(XR + (size_t)r * DM, YB + (size_t)r * DM, wpost, p.out + (size_t)r * DM, wpre, H + (size_t)r * DM, c.lane);
    }
}

__device__ __forceinline__ void phase_prep(const Params& p, const Ctx& c) {
    unsigned char* ws = p.ws;
    LAS float* scr = (LAS float*)(c.lds + c.wave * 16384);
    constexpr int J0 = 16 * 80, J1 = 16 * 32, J5 = 16 * 32, J6 = 16 * 64, J8 = 16 * 32, J10 = 16 * 160, J11 = 16 * 1, J12 = 32 * 32;
    constexpr int NIT = J0 + 4 * J1 + J5 + 2 * J6 + 2 * J8 + J10 + J11 + J12;
    for (int it = c.gw; it < NIT; it += c.NGW) {
        int r = it;
        if (r < J0) { transpose_item(p.in[IN_EWIN], 1024, 2464, (bf16*)(ws + WS_WEIN), 2560, 1, 0, r, scr, c.lane); continue; } r -= J0;
        if (r < 4 * J1) { const int q = r / J1, i = q >> 1, kv = q & 1;
            transpose_item(p.in[kv ? IN_XWV : IN_XWK] + (size_t)i * 1024 * 1024, 1024, 1024, (bf16*)(ws + WS_WMKV) + (size_t)(i * 2048 + kv * 1024) * 1024, 1024, 0, 0, r % J1, scr, c.lane); continue; } r -= 4 * J1;
        if (r < J5) { transpose_item(p.in[IN_EWOUT], 1024, 1024, (bf16*)(ws + WS_WEOUT), 1024, 0, 0, r, scr, c.lane); continue; } r -= J5;
        if (r < 2 * J6) { const int i = r / J6; transpose_item(p.in[IN_XWQG] + (size_t)i * 1024 * 2048, 1024, 2048, (bf16*)(ws + WS_WQG) + (size_t)i * 2048 * 1024, 2048, 0, 0, r % J6, scr, c.lane); continue; } r -= 2 * J6;
        if (r < 2 * J8) { const int i = r / J8; transpose_item(p.in[IN_XWO] + (size_t)i * 1024 * 1024, 1024, 1024, (bf16*)(ws + WS_WXO) + (size_t)i * 1024 * 1024, 1024, 0, 0, r % J8, scr, c.lane); continue; } r -= 2 * J8;
        if (r < J10) { transpose_item(p.in[IN_OWIN], 1024, 5152, (bf16*)(ws + WS_WOIN), 5120, 0, 0, r, scr, c.lane); continue; } r -= J10;
        if (r < J11) { transpose_item(p.in[IN_OWIN], 1024, 5152, (bf16*)(ws + WS_WDT), 32, 0, 5120, r, scr, c.lane); continue; } r -= J11;
        transpose_item(p.in[IN_OWOUT], 2048, 1024, (bf16*)(ws + WS_WOOUT), 1024, 0, 0, r, scr, c.lane);
    }
    const int gt = c.gw * 64 + c.lane, NGT = c.NGW * 64;
    { const float* wuq = p.in[IN_EWUQ]; const float* wuk = p.in[IN_EWUK]; bf16* WQ = (bf16*)(ws + WS_WQ);
      for (int idx = gt; idx < 1280 * 256; idx += NGT) { const int r = idx & 255, n = idx >> 8; float v;
          if (n < 1024) { const int h = n >> 7, cc = n & 127; const f32x4* a = (const f32x4*)(wuq + (size_t)(r * 8 + h) * 96); const f32x4* b = (const f32x4*)(wuk + (size_t)(cc * 8 + h) * 64); float s = 0.f;
#pragma unroll
              for (int i = 0; i < 16; ++i) { const f32x4 x = a[i], y = b[i]; s += (x.x * y.x + x.y * y.y) + (x.z * y.z + x.w * y.w); }
              v = s; }
          else { const int h = (n - 1024) >> 5, e = (n - 1024) & 31; v = wuq[(size_t)(r * 8 + h) * 96 + 64 + (e >> 1) + 16 * (e & 1)]; }
          WQ[(size_t)n * 256 + r] = (bf16)f2bf(v); } }
    { const float* wuv = p.in[IN_EWUV]; bf16* WT = (bf16*)(ws + WS_WUVT);
      for (int idx = gt; idx < 8 * 64 * 128; idx += NGT) { const int cc = idx & 127, v = (idx >> 7) & 63, h = idx >> 13; WT[idx] = (bf16)f2bf(wuv[(size_t)(cc * 8 + h) * 64 + v]); } }
    { float* R = (float*)(ws + WS_ROPE);
      for (int idx = gt; idx < 2052 * 16; idx += NGT) { const int pi = idx >> 4, j = idx & 15; const float pos = (float)(pi < TP ? pi : 16384 + (pi - TP));
          const float inv = powf(10000.f, -(float)j / 16.f); float sn, cs; sincosf(pos * inv, &sn, &cs); R[2 * idx] = cs; R[2 * idx + 1] = sn; } }
    bf16* H = (bf16*)(ws + WS_H); bf16* MN = (bf16*)(ws + WS_MN);
    for (int r = c.gw; r < MT + 4096; r += c.NGW) {
        if (r < MT) rms_row_to_bf16(r < MP ? p.in[IN_XP] + (size_t)r * DM : p.in[IN_XS] + (size_t)(r - MP) * DM, p.in[IN_NPM], H + (size_t)r * DM, c.lane);
        else { const int q = r - MT, i = q >> 11, m = q & 2047; rms_row_to_bf16(p.in[IN_MEM] + (size_t)m * DM, p.in[IN_NMEM] + i * DM, MN + (size_t)(i * 2048 + m) * DM, c.lane); }
    }
}
__device__ __forceinline__ void conv_unit(const Params& p, const Ctx& c, int u) {
    unsigned char* ws = p.ws;
    const bf16* GLU = (const bf16*)(ws + WS_GLU); const bf16* GATE = (const bf16*)(ws + WS_GATE); bf16* YCAT = (bf16*)(ws + WS_YCAT);
    LAS unsigned char* G = c.lds;
    LAS float* Y = (LAS float*)(c.lds + 63488);
    const bool samp = u >= 512; const int b = samp ? u - 512 : (u >> 6), tb = samp ? 0 : (u & 63), t0 = tb * 32;
    const int tid = c.tid;
    for (int ch = tid; ch < 62 * 64; ch += 512) {
        const int r = ch >> 6, c16 = ch & 63; u32x4 v = {0u, 0u, 0u, 0u};
        if (!samp) { const int t = t0 - 30 + r; if (t >= 0) v = *(const u32x4*)(GLU + ((size_t)b * TP + t) * 512 + c16 * 8); }
        else if (r < 30) { const f32x4* s = (const f32x4*)(p.in[IN_SCA] + ((size_t)b * 30 + r) * 512 + c16 * 8); const f32x4 a = s[0], d = s[1];
            v.x = pk2(a.x, a.y); v.y = pk2(a.z, a.w); v.z = pk2(d.x, d.y); v.w = pk2(d.z, d.w); }
        else if (r < 34) v = *(const u32x4*)(GLU + ((size_t)MP + 4 * b + (r - 30)) * 512 + c16 * 8);
        *(LAS u32x4*)(G + r * 1024 + c16 * 16) = v;
    }
    __syncthreads();
    {
        const int ch = tid; const float* cw = p.in[IN_ECW]; float w[31];
#pragma unroll
        for (int k = 0; k < 31; ++k) w[k] = cw[k * 512 + ch];
        const float bias = p.in[IN_ECB][ch];
        float g[62];
#pragma unroll
        for (int r = 0; r < 62; ++r) g[r] = bf2f(*(const LAS unsigned short*)(G + r * 1024 + ch * 2));
        f32x2 ge[31], go[30];
#pragma unroll
        for (int j = 0; j < 31; ++j) ge[j] = (f32x2){g[2 * j], g[2 * j + 1]};
#pragma unroll
        for (int j = 0; j < 30; ++j) go[j] = (f32x2){g[2 * j + 1], g[2 * j + 2]};
#pragma unroll
        for (int t = 0; t < 32; t += 2) { f32x2 a = {bias, bias};
#pragma unroll
            for (int k = 0; k < 31; ++k) { const f32x2 wv = {w[k], w[k]}; const f32x2 gp = ((t + k) & 1) ? go[(t + k - 1) >> 1] : ge[(t + k) >> 1]; a = __builtin_elementwise_fma(wv, gp, a); }
            Y[t * 512 + ch] = a.x; Y[(t + 1) * 512 + ch] = a.y; }
        if (!samp) { if (tb == 63) { float* o = p.out + O_CAP + (size_t)b * 30 * 512 + ch;
#pragma unroll
                for (int i = 0; i < 30; ++i) o[i * 512] = g[32 + i]; } }
        else { float* o = p.out + O_CAS + (size_t)b * 30 * 512 + ch; const float* hs = p.in[IN_SCA] + (size_t)b * 30 * 512 + ch;
#pragma unroll
            for (int i = 0; i < 30; ++i) o[i * 512] = (i < 26) ? hs[(4 + i) * 512] : g[4 + i]; }
    }
    __syncthreads();
    {
        const int lane = c.lane, c0 = lane * 8; const int ntok = samp ? 4 : 32;
        const f32x4* lw = (const f32x4*)(p.in[IN_ELNW] + c0); const f32x4* lb = (const f32x4*)(p.in[IN_ELNB] + c0);
        const f32x4 w0 = lw[0], w1 = lw[1], b0 = lb[0], b1 = lb[1];
        for (int i = 0; i < 4; ++i) { const int t = c.wave * 4 + i; if (t >= ntok) break;
            const LAS f32x4* yp = (const LAS f32x4*)(Y + t * 512 + c0); const f32x4 y0 = yp[0], y1 = yp[1];
            const float mean = wave_sum((y0.x + y0.y) + (y0.z + y0.w) + (y1.x + y1.y) + (y1.z + y1.w)) * (1.f / 512.f);
            const f32x4 d0 = y0 - mean, d1 = y1 - mean;
            const float var = wave_sum((d0.x * d0.x + d0.y * d0.y) + (d0.z * d0.z + d0.w * d0.w) + (d1.x * d1.x + d1.y * d1.y) + (d1.z * d1.z + d1.w * d1.w)) * (1.f / 512.f);
            const float rstd = rsqrtf(var + EPS);
            const size_t row = samp ? (size_t)MP + 4 * b + t : (size_t)b * TP + t0 + t;
            const u32x4 gt = *(const u32x4*)(GATE + row * 1024 + c0);
            const f32x4 n0 = d0 * rstd * w0 + b0, n1 = d1 * rstd * w1 + b1;
            const float o[8] = {siluf_(n0.x) * bflo(gt.x), siluf_(n0.y) * bfhi(gt.x), siluf_(n0.z) * bflo(gt.y), siluf_(n0.w) * bfhi(gt.y),
                                siluf_(n1.x) * bflo(gt.z), siluf_(n1.y) * bfhi(gt.z), siluf_(n1.z) * bflo(gt.w), siluf_(n1.w) * bfhi(gt.w)};
            store_bf<8>(YCAT + row * 1024 + c0, o); }
    }
    __syncthreads();
}
__device__ __forceinline__ void kvq_row(const Params& p, const Ctx& c, int r) {
    unsigned char* ws = p.ws; const int lane = c.lane;
    const bf16* CQ = (const bf16*)(ws + WS_CQ); bf16* CQN = (bf16*)(ws + WS_CQN); const bf16* KV = (const bf16*)(ws + WS_KVRAW); bf16* KP = (bf16*)(ws + WS_KP);
    { const u32x2 t = *(const u32x2*)(CQ + (size_t)r * 256 + lane * 4); const float v0 = bflo(t.x), v1 = bfhi(t.x), v2 = bflo(t.y), v3 = bfhi(t.y);
      const float s = rsqrtf(wave_sum((v0 * v0 + v1 * v1) + (v2 * v2 + v3 * v3)) * (1.f / 256.f) + EPS); const f32x4 w = *(const f32x4*)(p.in[IN_EQN] + lane * 4);
      const float o[4] = {v0 * s * w.x, v1 * s * w.y, v2 * s * w.z, v3 * s * w.w}; store_bf<4>(CQN + (size_t)r * 256 + lane * 4, o); }
    float* ock = r < MP ? p.out + O_CKVP + (size_t)r * 128 : p.out + O_CKVS + (size_t)(r - MP) * 128;
    float* okr = r < MP ? p.out + O_KRP + (size_t)r * 32 : p.out + O_KRS + (size_t)(r - MP) * 32;
    { const unsigned t = *(const unsigned*)(KV + (size_t)r * 256 + lane * 2); const float v0 = bflo(t), v1 = bfhi(t);
      const float s = rsqrtf(wave_sum(v0 * v0 + v1 * v1) * (1.f / 128.f) + EPS); const f32x2 w = *(const f32x2*)(p.in[IN_EKVN] + lane * 2);
      const float o[2] = {v0 * s * w.x, v1 * s * w.y}; *(f32x2*)(ock + lane * 2) = (f32x2){o[0], o[1]}; store_bf<2>(KP + (size_t)r * 160 + lane * 2, o); }
    if (lane < 16) { const float x1 = bf2f(KV[(size_t)r * 256 + 128 + lane]), x2 = bf2f(KV[(size_t)r * 256 + 144 + lane]);
        const float* rp = (const float*)(ws + WS_ROPE) + ((size_t)pos_index(r) * 16 + lane) * 2; const float cs = rp[0], sn = rp[1];
        const float o[2] = {x1 * cs - x2 * sn, x1 * sn + x2 * cs}; okr[lane] = o[0]; okr[16 + lane] = o[1]; store_bf<2>(KP + (size_t)r * 160 + 128 + 2 * lane, o); }
}
__device__ __forceinline__ void phase_conv(const Params& p, const Ctx& c) {
    for (int u = c.cu; u < 512 + 32; u += c.G) conv_unit(p, c, u);
    for (int r = c.gw; r < MT; r += 2 * c.NGW) { kvq_row(p, c, r); if (r + c.NGW < MT) kvq_row(p, c, r + c.NGW); }
}
constexpr int KS = 336;
#define EXP2(x) __builtin_amdgcn_exp2f(x)
__device__ __forceinline__ void mla_prompt_unit(const Params& p, const Ctx& c, int b, int tb) {
    unsigned char* ws = p.ws;
    const bf16* QP = (const bf16*)(ws + WS_QP); const bf16* KP = (const bf16*)(ws + WS_KP); const bf16* GATE = (const bf16*)(ws + WS_GATE); bf16* YCAT = (bf16*)(ws + WS_YCAT);
    const bf16* WUVT = (const bf16*)(ws + WS_WUVT);
    const int tid = c.tid, lane = c.lane, r32 = lane & 31, hi = lane >> 5, head = c.wave, t0 = tb * 32;
    const size_t qrow = (size_t)b * TP + t0 + r32;
    bf16x8 qf[10];
#pragma unroll
    for (int s = 0; s < 8; ++s) qf[s] = *(const bf16x8*)(QP + qrow * 1280 + head * 128 + 16 * s + 8 * hi);
#pragma unroll
    for (int s = 0; s < 2; ++s) qf[8 + s] = *(const bf16x8*)(QP + qrow * 1280 + 1024 + head * 32 + 16 * s + 8 * hi);
    f32x16 o0 = {}, o1 = {}, o2 = {}, o3 = {}; float m = -1e30f, l = 0.f;
    const int ntile = (t0 + 32 + 63) >> 6;
    const bf16* kbase = KP + (size_t)b * TP * 160;
    u32x4 rg[3];
    const unsigned gvo = (unsigned)tid * 16u;
    const int lo0 = (tid / 20) * KS + (tid % 20) * 16, lo1 = ((tid + 512) / 20) * KS + ((tid + 512) % 20) * 16, lo2 = ((tid + 1024) / 20) * KS + ((tid + 1024) % 20) * 16;
#define MLA_LOAD(j) do { const char* t_ = (const char*)kbase + (size_t)(j) * 20480; rg[0] = *(const u32x4*)(t_ + gvo); rg[1] = *(const u32x4*)(t_ + gvo + 8192); if (tid < 256) rg[2] = *(const u32x4*)(t_ + gvo + 16384); } while (0)
#define MLA_STORE(buf) do { *(LAS u32x4*)((buf) + lo0) = rg[0]; *(LAS u32x4*)((buf) + lo1) = rg[1]; if (tid < 256) *(LAS u32x4*)((buf) + lo2) = rg[2]; } while (0)
    MLA_LOAD(0); MLA_STORE(c.lds); __syncthreads();
    const int vofs = (4 * hi + ((lane & 15) >> 2)) * KS + (((lane >> 4) & 1) * 16 + (lane & 3) * 4) * 2;
    for (int j = 0; j < ntile; ++j) {
        asm volatile("; MLA_TILE_BEGIN");
        LAS unsigned char* cur = c.lds + (j & 1) * (64 * KS); LAS unsigned char* nxt = c.lds + ((j + 1) & 1) * (64 * KS);
        if (j + 1 < ntile) MLA_LOAD(j + 1);
        const bool two = (64 * j + 32 <= t0 + 31);
        f32x16 p0 = {}, p1 = {};
        const LAS unsigned char* ka = cur + r32 * KS + hi * 16;
        { bf16x8 kf[10];
#pragma unroll
          for (int s = 0; s < 10; ++s) kf[s] = *(const LAS bf16x8*)(ka + s * 32);
          SCHED_FENCE(); PRIO_HI();
#pragma unroll
          for (int s = 0; s < 10; ++s) p0 = mfma32(kf[s], qf[s], p0);
          PRIO_LO(); SCHED_FENCE();
          if (two) {
#pragma unroll
            for (int s = 0; s < 10; ++s) kf[s] = *(const LAS bf16x8*)(ka + 32 * KS + s * 32);
            SCHED_FENCE(); PRIO_HI();
#pragma unroll
            for (int s = 0; s < 10; ++s) p1 = mfma32(kf[s], qf[s], p1);
            PRIO_LO(); SCHED_FENCE();
          } }
        if (64 * j + 63 > t0) { const int t = t0 + r32;
#pragma unroll
            for (int r = 0; r < 16; ++r) { const int key = 64 * j + crow(r, hi); if (key > t) p0[r] = -INFINITY; if (key + 32 > t) p1[r] = -INFINITY; } }
        float mx = max2f(p0[0], p1[0]);
#pragma unroll
        for (int r = 1; r < 16; ++r) mx = max3f(mx, p0[r], p1[r]);
        mx = max2f(mx, xhalf(mx));
        if (__builtin_amdgcn_ballot_w64(mx > m) != 0ull) {
            const float mn = max2f(m, mx), alpha = EXP2(m - mn); m = mn;
            l *= alpha; o0 *= alpha; o1 *= alpha; o2 *= alpha; o3 *= alpha;
        }
        float rs = 0.f;
#pragma unroll
        for (int r = 0; r < 16; ++r) { p0[r] = EXP2(p0[r] - m); p1[r] = EXP2(p1[r] - m); rs += p0[r] + p1[r]; }
        l += rs;
        const bf16x8 pf0 = pack8(p0[0], p0[1], p0[2], p0[3], p0[4], p0[5], p0[6], p0[7]), pf1 = pack8(p0[8], p0[9], p0[10], p0[11], p0[12], p0[13], p0[14], p0[15]);
        const bf16x8 pf2 = pack8(p1[0], p1[1], p1[2], p1[3], p1[4], p1[5], p1[6], p1[7]), pf3 = pack8(p1[8], p1[9], p1[10], p1[11], p1[12], p1[13], p1[14], p1[15]);
        const LAS unsigned char* va = cur + vofs;
#define MLA_PV(ks, pf) do { const LAS unsigned char* v_ = va + (16 * (ks)) * KS; \
            const s16x4 a0_ = tr_read(v_), a1_ = tr_read(v_ + 8 * KS), b0_ = tr_read(v_ + 64), b1_ = tr_read(v_ + 8 * KS + 64), c0_ = tr_read(v_ + 128), c1_ = tr_read(v_ + 8 * KS + 128), d0_ = tr_read(v_ + 192), d1_ = tr_read(v_ + 8 * KS + 192); \
            SCHED_FENCE(); PRIO_HI(); \
            o0 = mfma32(cat4(a0_, a1_), pf, o0); o1 = mfma32(cat4(b0_, b1_), pf, o1); o2 = mfma32(cat4(c0_, c1_), pf, o2); o3 = mfma32(cat4(d0_, d1_), pf, o3); \
            PRIO_LO(); SCHED_FENCE(); } while (0)
        MLA_PV(0, pf0); MLA_PV(1, pf1);
        if (two) { MLA_PV(2, pf2); MLA_PV(3, pf3); }
        if (j + 1 < ntile) MLA_STORE(nxt);
        __syncthreads();
        asm volatile("; MLA_TILE_END");
    }
    l += xhalf(l); const float inv = 1.f / l;
    o0 *= inv; o1 *= inv; o2 *= inv; o3 *= inv;
    f32x16 y0 = {}, y1 = {};
    const bf16* wp = WUVT + (size_t)head * 64 * 128 + r32 * 128 + 4 * hi;
#define MLA_UV(kc, of) do { const bf16* w_ = wp + 16 * (kc); const u32x2 a0_ = *(const u32x2*)w_, a1_ = *(const u32x2*)(w_ + 8), b0_ = *(const u32x2*)(w_ + 32 * 128), b1_ = *(const u32x2*)(w_ + 32 * 128 + 8); \
        const bf16x8 A0_ = __builtin_bit_cast(bf16x8, (u32x4){a0_.x, a0_.y, a1_.x, a1_.y}), A1_ = __builtin_bit_cast(bf16x8, (u32x4){b0_.x, b0_.y, b1_.x, b1_.y}); \
        y0 = mfma32(A0_, of, y0); y1 = mfma32(A1_, of, y1); } while (0)
#define PK_LO(o) pack8(o[0], o[1], o[2], o[3], o[4], o[5], o[6], o[7])
#define PK_HI(o) pack8(o[8], o[9], o[10], o[11], o[12], o[13], o[14], o[15])
    MLA_UV(0, PK_LO(o0)); MLA_UV(1, PK_HI(o0)); MLA_UV(2, PK_LO(o1)); MLA_UV(3, PK_HI(o1));
    MLA_UV(4, PK_LO(o2)); MLA_UV(5, PK_HI(o2)); MLA_UV(6, PK_LO(o3)); MLA_UV(7, PK_HI(o3));
    const size_t obase = qrow * 1024 + 512 + head * 64 + 4 * hi;
#pragma unroll
    for (int g = 0; g < 4; ++g) {
        { const u32x2 gt = *(const u32x2*)(GATE + obase + 8 * g); const float o[4] = {y0[4 * g] * bflo(gt.x), y0[4 * g + 1] * bfhi(gt.x), y0[4 * g + 2] * bflo(gt.y), y0[4 * g + 3] * bfhi(gt.y)}; store_bf<4>(YCAT + obase + 8 * g, o); }
        { const u32x2 gt = *(const u32x2*)(GATE + obase + 32 + 8 * g); const float o[4] = {y1[4 * g] * bflo(gt.x), y1[4 * g + 1] * bfhi(gt.x), y1[4 * g + 2] * bflo(gt.y), y1[4 * g + 3] * bfhi(gt.y)}; store_bf<4>(YCAT + obase + 32 + 8 * g, o); }
    }
}
__device__ __forceinline__ void mla_sample_wave(const Params& p, const Ctx& c, int b, int sp) {
    unsigned char* ws = p.ws;
    const bf16* QP = (const bf16*)(ws + WS_QP); const bf16* KP = (const bf16*)(ws + WS_KP); float* PART = (float*)(ws + WS_PART);
    const int lane = c.lane, r32 = lane & 31, hi = lane >> 5, head = r32 & 7, tok = r32 >> 3;
    const size_t qrow = (size_t)MP + 4 * b + tok;
    bf16x8 qf[10];
#pragma unroll
    for (int s = 0; s < 8; ++s) qf[s] = *(const bf16x8*)(QP + qrow * 1280 + head * 128 + 16 * s + 8 * hi);
#pragma unroll
    for (int s = 0; s < 2; ++s) qf[8 + s] = *(const bf16x8*)(QP + qrow * 1280 + 1024 + head * 32 + 16 * s + 8 * hi);
    f32x16 o0 = {}, o1 = {}, o2 = {}, o3 = {}; float m = -1e30f, l = 0.f;
    LAS unsigned char* buf = c.lds + c.wave * (32 * KS);
    const int* pt = (const int*)p.in[IN_PT] + b * 128;
    const int ntile = (sp == 63) ? 9 : 8;
    const int vofs = (4 * hi + ((lane & 15) >> 2)) * KS + (((lane >> 4) & 1) * 16 + (lane & 3) * 4) * 2;
    for (int j = 0; j < ntile; ++j) {
        if (j < 8) {
            const int key0 = 256 * sp + 32 * j; const size_t prow = (size_t)pt[key0 >> 7] * 128 + (key0 & 127);
            const f32x4* sc = (const f32x4*)(p.in[IN_CCKV] + prow * 128);
            { const f32x4* sp_ = sc + lane; LAS unsigned char* dp_ = buf + (lane >> 5) * KS + (lane & 31) * 8;
#pragma unroll 4
              for (int i = 0; i < 16; ++i) { const f32x4 v = __builtin_nontemporal_load(sp_ + 64 * i); u32x2 w; w.x = pk2(v.x, v.y); w.y = pk2(v.z, v.w); *(LAS u32x2*)(dp_ + i * 2 * KS) = w; } }
            const float* sr = p.in[IN_CKR] + prow * 32;
#pragma unroll
            for (int i = 0; i < 2; ++i) { const int cmb = lane + 64 * i, row = cmb >> 2, i4 = cmb & 3; const f32x4 x1 = ldnt4(sr + row * 32 + 4 * i4), x2 = ldnt4(sr + row * 32 + 16 + 4 * i4);
                u32x4 w; w.x = pk2(x1.x, x2.x); w.y = pk2(x1.y, x2.y); w.z = pk2(x1.z, x2.z); w.w = pk2(x1.w, x2.w); *(LAS u32x4*)(buf + row * KS + 256 + i4 * 16) = w; }
        } else {
            { LAS u32x4* zp = (LAS u32x4*)buf + lane;
#pragma unroll
              for (int i = 0; i < 11; ++i) if (lane + 64 * i < 672) zp[64 * i] = (u32x4){0u, 0u, 0u, 0u}; }
            LDS_WAIT();
            { const bf16* src = KP + ((size_t)MP + 4 * b) * 160;
              const int r0 = lane / 20, c0 = lane - 20 * r0; *(LAS u32x4*)(buf + r0 * KS + c0 * 16) = *(const u32x4*)(src + lane * 8);
              if (lane < 16) { const int ch = 64 + lane, r1 = 3, c1 = ch - 60; *(LAS u32x4*)(buf + r1 * KS + c1 * 16) = *(const u32x4*)(src + ch * 8); } }
        }
        LDS_WAIT();
        f32x16 p0 = {};
        const LAS unsigned char* ka = buf + r32 * KS + hi * 16;
        { bf16x8 kf[10];
#pragma unroll
          for (int s = 0; s < 10; ++s) kf[s] = *(const LAS bf16x8*)(ka + s * 32);
          SCHED_FENCE();
#pragma unroll
          for (int s = 0; s < 10; ++s) p0 = mfma32(kf[s], qf[s], p0);
          SCHED_FENCE(); }
        if (j == 8) {
#pragma unroll
            for (int r = 0; r < 16; ++r) { const int key = crow(r, hi); if (key > tok) p0[r] = -INFINITY; }
        }
        float mx = max3f(p0[0], p0[1], p0[2]);
#pragma unroll
        for (int r = 3; r < 15; r += 2) mx = max3f(mx, p0[r], p0[r + 1]);
        mx = max2f(mx, p0[15]);
        mx = max2f(mx, xhalf(mx));
        if (__builtin_amdgcn_ballot_w64(mx > m) != 0ull) {
            const float mn = max2f(m, mx), alpha = EXP2(m - mn); m = mn;
            l *= alpha; o0 *= alpha; o1 *= alpha; o2 *= alpha; o3 *= alpha;
        }
        float rs = 0.f;
#pragma unroll
        for (int r = 0; r < 16; ++r) { p0[r] = EXP2(p0[r] - m); rs += p0[r]; }
        l += rs;
        const bf16x8 pf0 = pack8(p0[0], p0[1], p0[2], p0[3], p0[4], p0[5], p0[6], p0[7]), pf1 = pack8(p0[8], p0[9], p0[10], p0[11], p0[12], p0[13], p0[14], p0[15]);
        const LAS unsigned char* va = buf + vofs;
        MLA_PV(0, pf0); MLA_PV(1, pf1);
        LDS_WAIT();
    }
    l += xhalf(l);
    float* po = PART + ((size_t)b * 64 + sp) * PART_STRIDE + (unsigned)lane;
#pragma unroll
    for (int r = 0; r < 16; ++r) { po[r * 64] = o0[r]; po[1024 + r * 64] = o1[r]; po[2048 + r * 64] = o2[r]; po[3072 + r * 64] = o3[r]; }
    if (lane < 32) { po[4096] = m; po[4096 + 32] = l; }
}
__device__ __forceinline__ void phase_mla(const Params& p, const Ctx& c) {
    const bool sfirst = (c.cu & 1) != 0;
    if (sfirst) { for (int u = c.cu; u < 256; u += c.G) mla_sample_wave(p, c, u >> 3, (u & 7) * 8 + c.wave); __syncthreads(); }
    for (int i = c.cu; i < 512; i += c.G) { const int k = (i < 256) ? i : 767 - i;
        mla_prompt_unit(p, c, k & 7, 63 - (k >> 3)); }
    __syncthreads();
    if (!sfirst) { for (int u = c.cu; u < 256; u += c.G) mla_sample_wave(p, c, u >> 3, (u & 7) * 8 + c.wave); __syncthreads(); }
}
__device__ __forceinline__ void mla_combine_unit(const Params& p, const Ctx& c, int b) {
    unsigned char* ws = p.ws; const float* PART = (const float*)(ws + WS_PART) + (size_t)b * 64 * PART_STRIDE;
    const bf16* GATE = (const bf16*)(ws + WS_GATE); bf16* YCAT = (bf16*)(ws + WS_YCAT);
    LAS float* OS = (LAS float*)c.lds;
    const int tid = c.tid, q = tid & 31;
    float M = -1e30f;
#pragma unroll 16
    for (int s = 0; s < 64; ++s) M = fmaxf(M, PART[(size_t)s * PART_STRIDE + 4096 + q]);
    float L = 0.f, acc[8] = {0.f, 0.f, 0.f, 0.f, 0.f, 0.f, 0.f, 0.f};
#pragma unroll 1
    for (int s0 = 0; s0 < 64; s0 += 8) {
        float ms[8], ls[8], ov[8][8];
#pragma unroll
        for (int j = 0; j < 8; ++j) { const float* ps = PART + (size_t)(s0 + j) * PART_STRIDE; ms[j] = ps[4096 + q]; ls[j] = ps[4096 + 32 + q];
#pragma unroll
            for (int i = 0; i < 8; ++i) ov[j][i] = ps[tid + 512 * i]; }
#pragma unroll
        for (int j = 0; j < 8; ++j) { const float w = EXP2(ms[j] - M); L += w * ls[j];
#pragma unroll
            for (int i = 0; i < 8; ++i) acc[i] += w * ov[j][i]; }
    }
    const float inv = 1.f / L;
#pragma unroll
    for (int i = 0; i < 8; ++i) { const int e = tid + 512 * i, dbr = e >> 6, ln = e & 63; const int cc = 32 * (dbr >> 4) + crow(dbr & 15, ln >> 5); OS[q * 129 + cc] = acc[i] * inv; }
    __syncthreads();
    { const int qq = tid >> 4, v0 = (tid & 15) * 4, head = qq & 7, tok = qq >> 3; const float* wuv = p.in[IN_EWUV];
      float y[4] = {0.f, 0.f, 0.f, 0.f};
      for (int cc = 0; cc < 128; ++cc) { const float ov = OS[qq * 129 + cc]; const f32x4 w = *(const f32x4*)(wuv + ((size_t)cc * 8 + head) * 64 + v0); y[0] += ov * w.x; y[1] += ov * w.y; y[2] += ov * w.z; y[3] += ov * w.w; }
      const size_t ob = ((size_t)MP + 4 * b + tok) * 1024 + 512 + head * 64 + v0; const u32x2 gt = *(const u32x2*)(GATE + ob);
      const float o[4] = {y[0] * bflo(gt.x), y[1] * bfhi(gt.x), y[2] * bflo(gt.y), y[3] * bfhi(gt.y)}; store_bf<4>(YCAT + ob, o); }
    __syncthreads();
}
constexpr int XS = 528;
constexpr int XV = 576;
template <bool samp> __device__ __forceinline__ void xattn_unit(const Params& p, const Ctx& c, int layer, int b, int h, int qb, int dh_lo, int dh_hi) {
    unsigned char* ws = p.ws;
    const bf16* XQ = (const bf16*)(ws + WS_XQ); const bf16* XG = (const bf16*)(ws + WS_XG); bf16* XO = (bf16*)(ws + WS_XO);
    const int tid = c.tid, lane = c.lane, r32 = lane & 31, hi = lane >> 5;
    const size_t row = samp ? (size_t)MP + 4 * b + (r32 & 3) : (size_t)b * TP + qb * 256 + c.wave * 32 + r32;
    const bool active = !samp || c.wave == 0;
    const bf16* kb16 = (const bf16*)(ws + WS_MKV) + ((size_t)(layer * 2 + 0) * 2048 + (size_t)b * 256) * 1024 + h * 256;
    const bf16* vb16 = (const bf16*)(ws + WS_MKV) + ((size_t)(layer * 2 + 1) * 2048 + (size_t)b * 256) * 1024 + h * 256;
    const float* kf32 = p.in[IN_CMK] + ((size_t)(layer * 32 + b) * 256) * 1024 + h * 256;
    const float* vf32 = p.in[IN_CMV] + ((size_t)(layer * 32 + b) * 256) * 1024 + h * 256;
    u32x4 rgk[4], rgv[4];
    const unsigned voff = (unsigned)((tid >> 5) * 1024 + (tid & 31) * 8);
    const unsigned loff = (unsigned)((tid >> 5) * XS + (tid & 31) * 16), loffv = (unsigned)((tid >> 5) * XV + (tid & 31) * 16);
#define XA_LOAD(rg, p16, kt) do { if (!samp) { const bf16* t_ = (p16) + (size_t)(64 * (kt)) * 1024; \
            _Pragma("unroll") for (int i_ = 0; i_ < 4; ++i_) rg[i_] = *(const u32x4*)(t_ + (size_t)i_ * 16 * 1024 + voff); } } while (0)
#define XA_STORE(buf, lo_, st_, rg, p32, kt) do { if (!samp) { _Pragma("unroll") for (int i_ = 0; i_ < 4; ++i_) *(LAS u32x4*)((buf) + (lo_) + i_ * 16 * (st_)) = rg[i_]; } \
        else { const float* t_ = (p32) + (size_t)(64 * (kt)) * 1024 + voff;        \
            f32x4 a_[4], d_[4]; _Pragma("unroll") for (int i_ = 0; i_ < 4; ++i_) { const f32x4* s_ = (const f32x4*)(t_ + (size_t)i_ * 16 * 1024); a_[i_] = __builtin_nontemporal_load(s_); d_[i_] = __builtin_nontemporal_load(s_ + 1); } \
            _Pragma("unroll") for (int i_ = 0; i_ < 4; ++i_) *(LAS u32x4*)((buf) + (lo_) + i_ * 16 * (st_)) = (u32x4){pk2(a_[i_].x, a_[i_].y), pk2(a_[i_].z, a_[i_].w), pk2(d_[i_].x, d_[i_].y), pk2(d_[i_].z, d_[i_].w)}; } } while (0)
    LAS unsigned char* kbuf = c.lds; LAS unsigned char* vbuf = c.lds + 64 * XS;
    bf16x8 qf[16];
#pragma unroll
    for (int s = 0; s < 16; ++s) qf[s] = *(const bf16x8*)(XQ + row * 1024 + h * 256 + 16 * s + 8 * hi);
    const int vofs = (4 * hi + ((lane & 15) >> 2)) * XV + (((lane >> 4) & 1) * 16 + (lane & 3) * 4) * 2;
    const LAS unsigned char* ka = kbuf + r32 * XS + hi * 16;
#pragma unroll 1
    for (int dh = dh_lo; dh < dh_hi; ++dh) {
        f32x16 o0 = {}, o1 = {}, o2 = {}, o3 = {}; float m = -1e30f, l = 0.f;
        XA_LOAD(rgk, kb16, 0); XA_LOAD(rgv, vb16, 0);
#pragma unroll 1
        for (int kt = 0; kt < 4; ++kt) {
            __syncthreads();
            XA_STORE(kbuf, loff, XS, rgk, kf32, kt); XA_STORE(vbuf, loffv, XV, rgv, vf32, kt);
            __syncthreads();
            if (kt < 3) { XA_LOAD(rgk, kb16, kt + 1); XA_LOAD(rgv, vb16, kt + 1); }
            if (active) {
                f32x16 p0 = {}, p1 = {};
#pragma unroll
                for (int s2 = 0; s2 < 8; ++s2) { bf16x8 ka_[2], kb_[2];
#pragma unroll
                    for (int j = 0; j < 2; ++j) { ka_[j] = *(const LAS bf16x8*)(ka + (2 * s2 + j) * 32); kb_[j] = *(const LAS bf16x8*)(ka + 32 * XS + (2 * s2 + j) * 32); }
                    SCHED_FENCE();
#pragma unroll
                    for (int j = 0; j < 2; ++j) { p0 = mfma32(ka_[j], qf[2 * s2 + j], p0); p1 = mfma32(kb_[j], qf[2 * s2 + j], p1); }
                    SCHED_FENCE(); }
                float mx = fmaxf(p0[0], p1[0]);
#pragma unroll
                for (int r = 1; r < 16; ++r) mx = fmaxf(mx, fmaxf(p0[r], p1[r]));
                mx = fmaxf(mx, xhalf(mx));
                const float mn = fmaxf(m, mx), alpha = EXP2(m - mn); m = mn;
                float rs = 0.f;
#pragma unroll
                for (int r = 0; r < 16; ++r) { p0[r] = EXP2(p0[r] - mn); p1[r] = EXP2(p1[r] - mn); rs += p0[r] + p1[r]; }
                l = l * alpha + rs;
                o0 *= alpha; o1 *= alpha; o2 *= alpha; o3 *= alpha;
                const bf16x8 pf0 = pack8(p0[0], p0[1], p0[2], p0[3], p0[4], p0[5], p0[6], p0[7]), pf1 = pack8(p0[8], p0[9], p0[10], p0[11], p0[12], p0[13], p0[14], p0[15]);
                const bf16x8 pf2 = pack8(p1[0], p1[1], p1[2], p1[3], p1[4], p1[5], p1[6], p1[7]), pf3 = pack8(p1[8], p1[9], p1[10], p1[11], p1[12], p1[13], p1[14], p1[15]);
                const LAS unsigned char* va = vbuf + vofs + dh * 256;
#define XA_PV(ks, pf) do { const LAS unsigned char* v_ = va + (16 * (ks)) * XV; \
                    const s16x4 a0_ = tr_read(v_), a1_ = tr_read(v_ + 8 * XV), b0_ = tr_read(v_ + 64), b1_ = tr_read(v_ + 8 * XV + 64), c0_ = tr_read(v_ + 128), c1_ = tr_read(v_ + 8 * XV + 128), d0_ = tr_read(v_ + 192), d1_ = tr_read(v_ + 8 * XV + 192); \
                    SCHED_FENCE(); PRIO_HI(); \
                    o0 = mfma32(cat4(a0_, a1_), pf, o0); o1 = mfma32(cat4(b0_, b1_), pf, o1); o2 = mfma32(cat4(c0_, c1_), pf, o2); o3 = mfma32(cat4(d0_, d1_), pf, o3); \
                    PRIO_LO(); SCHED_FENCE(); } while (0)
                XA_PV(0, pf0); XA_PV(1, pf1); XA_PV(2, pf2); XA_PV(3, pf3);
            }
        }
        if (active && (!samp || r32 < 4)) {
            l += xhalf(l);
            const float inv = 1.f / l; const size_t ob = row * 1024 + h * 256 + dh * 128 + 4 * hi;
#define XA_OUT(db, o) do { _Pragma("unroll") for (int g = 0; g < 4; ++g) { const size_t a = ob + 32 * (db) + 8 * g; const u32x2 gt = *(const u32x2*)(XG + a); \
                const float ov[4] = {o[4 * g] * inv * bflo(gt.x), o[4 * g + 1] * inv * bfhi(gt.x), o[4 * g + 2] * inv * bflo(gt.y), o[4 * g + 3] * inv * bfhi(gt.y)}; store_bf<4>(XO + a, ov); } } while (0)
            XA_OUT(0, o0); XA_OUT(1, o1); XA_OUT(2, o2); XA_OUT(3, o3);
        }
    }
    __syncthreads();
}
__device__ __forceinline__ void xattn_prompt_unit(const Params& p, const Ctx& c, int layer, int b, int h, int qb) {
    unsigned char* ws = p.ws;
    const bf16* XQ = (const bf16*)(ws + WS_XQ); const bf16* XG = (const bf16*)(ws + WS_XG); bf16* XO = (bf16*)(ws + WS_XO);
    const int tid = c.tid, lane = c.lane, r32 = lane & 31, hi = lane >> 5;
    const size_t row = (size_t)b * TP + qb * 256 + c.wave * 32 + r32;
    const bf16* kb16 = (const bf16*)(ws + WS_MKV) + ((size_t)(layer * 2 + 0) * 2048 + (size_t)b * 256) * 1024 + h * 256;
    const bf16* vb16 = (const bf16*)(ws + WS_MKV) + ((size_t)(layer * 2 + 1) * 2048 + (size_t)b * 256) * 1024 + h * 256;
    u32x4 rg[4];
    const unsigned voff = (unsigned)((tid >> 5) * 1024 + (tid & 31) * 8);
    const unsigned loff = (unsigned)((tid >> 5) * XS + (tid & 31) * 16), loffv = (unsigned)((tid >> 5) * XV + (tid & 31) * 16);
#define XP_LOAD(p16, kt) do { const bf16* t_ = (p16) + (size_t)(64 * (kt)) * 1024; _Pragma("unroll") for (int i_ = 0; i_ < 4; ++i_) rg[i_] = *(const u32x4*)(t_ + (size_t)i_ * 16 * 1024 + voff); } while (0)
#define XP_STORE(buf, lo_, st_) do { _Pragma("unroll") for (int i_ = 0; i_ < 4; ++i_) *(LAS u32x4*)((buf) + (lo_) + i_ * 16 * (st_)) = rg[i_]; } while (0)
    LAS unsigned char* kbuf = c.lds; LAS unsigned char* vbuf = c.lds + 64 * XS;
    bf16x8 pf[16]; float mk0 = 0.f, mk1 = 0.f, mk2 = 0.f, m = -1e30f, l = 0.f;
    XP_LOAD(kb16, 0);
    {
        bf16x8 qf[16];
#pragma unroll
        for (int s = 0; s < 16; ++s) qf[s] = *(const bf16x8*)(XQ + row * 1024 + h * 256 + 16 * s + 8 * hi);
        const LAS unsigned char* ka = kbuf + r32 * XS + hi * 16;
#pragma unroll
        for (int kt = 0; kt < 4; ++kt) {
            __syncthreads();
            XP_STORE(kbuf, loff, XS);
            __syncthreads();
            if (kt < 3) XP_LOAD(kb16, kt + 1); else XP_LOAD(vb16, 0);
            f32x16 p0 = {}, p1 = {};
#pragma unroll
            for (int s2 = 0; s2 < 8; ++s2) { bf16x8 ka_[2], kb_[2];
#pragma unroll
                for (int j = 0; j < 2; ++j) { ka_[j] = *(const LAS bf16x8*)(ka + (2 * s2 + j) * 32); kb_[j] = *(const LAS bf16x8*)(ka + 32 * XS + (2 * s2 + j) * 32); }
                SCHED_FENCE(); PRIO_HI();
#pragma unroll
                for (int j = 0; j < 2; ++j) { p0 = mfma32(ka_[j], qf[2 * s2 + j], p0); p1 = mfma32(kb_[j], qf[2 * s2 + j], p1); }
                PRIO_LO(); SCHED_FENCE(); }
            float mx = fmaxf(p0[0], p1[0]);
#pragma unroll
            for (int r = 1; r < 16; ++r) mx = fmaxf(mx, fmaxf(p0[r], p1[r]));
            mx = fmaxf(mx, xhalf(mx));
            const float mn = fmaxf(m, mx); l *= EXP2(m - mn); m = mn;
            if (kt == 0) mk0 = mn; else if (kt == 1) mk1 = mn; else if (kt == 2) mk2 = mn;
            float rs = 0.f;
#pragma unroll
            for (int r = 0; r < 16; ++r) { p0[r] = EXP2(p0[r] - mn); p1[r] = EXP2(p1[r] - mn); rs += p0[r] + p1[r]; }
            l += rs;
            pf[4 * kt + 0] = pack8(p0[0], p0[1], p0[2], p0[3], p0[4], p0[5], p0[6], p0[7]); pf[4 * kt + 1] = pack8(p0[8], p0[9], p0[10], p0[11], p0[12], p0[13], p0[14], p0[15]);
            pf[4 * kt + 2] = pack8(p1[0], p1[1], p1[2], p1[3], p1[4], p1[5], p1[6], p1[7]); pf[4 * kt + 3] = pack8(p1[8], p1[9], p1[10], p1[11], p1[12], p1[13], p1[14], p1[15]);
        }
    }
    l += xhalf(l);
    { const float inv = 1.f / l;
#pragma unroll
      for (int i = 0; i < 16; ++i) { const float f = (i < 4 ? EXP2(mk0 - m) : i < 8 ? EXP2(mk1 - m) : i < 12 ? EXP2(mk2 - m) : 1.f) * inv; u32x4 w = __builtin_bit_cast(u32x4, pf[i]);
          w.x = pk2(bflo(w.x) * f, bfhi(w.x) * f); w.y = pk2(bflo(w.y) * f, bfhi(w.y) * f); w.z = pk2(bflo(w.z) * f, bfhi(w.z) * f); w.w = pk2(bflo(w.w) * f, bfhi(w.w) * f); pf[i] = __builtin_bit_cast(bf16x8, w); } }
    const int vofs = (4 * hi + ((lane & 15) >> 2)) * XV + (((lane >> 4) & 1) * 16 + (lane & 3) * 4) * 2;
#pragma unroll
    for (int dh = 0; dh < 2; ++dh) {
        f32x16 o0 = {}, o1 = {}, o2 = {}, o3 = {};
#pragma unroll
        for (int vt = 0; vt < 4; ++vt) {
            __syncthreads();
            XP_STORE(vbuf, loffv, XV);
            __syncthreads();
            if (vt < 3) XP_LOAD(vb16, vt + 1); else if (dh == 0) XP_LOAD(vb16, 0);
            const LAS unsigned char* va = vbuf + vofs + dh * 256;
            XA_PV(0, pf[4 * vt + 0]); XA_PV(1, pf[4 * vt + 1]); XA_PV(2, pf[4 * vt + 2]); XA_PV(3, pf[4 * vt + 3]);
        }
        const float inv = 1.f; const size_t ob = row * 1024 + h * 256 + dh * 128 + 4 * hi;
        XA_OUT(0, o0); XA_OUT(1, o1); XA_OUT(2, o2); XA_OUT(3, o3);
    }
    __syncthreads();
}
__device__ __forceinline__ void phase_xattn(const Params& p, const Ctx& c, int layer) {
    const int vcu = (c.G % 8 == 0) ? (c.cu & 7) * (c.G >> 3) + (c.cu >> 3) : c.cu;
    for (int u = vcu; u < 256; u += c.G) xattn_prompt_unit(p, c, layer, u >> 5, (u >> 3) & 3, u & 7);
    for (int s = vcu; s < 256; s += c.G) xattn_unit<true>(p, c, layer, s >> 3, (s >> 1) & 3, 0, s & 1, (s & 1) + 1);
}
__device__ __forceinline__ void phase_conv4(const Params& p, const Ctx& c) {
    unsigned char* ws = p.ws; const bf16* XBC = (const bf16*)(ws + WS_XBC); bf16* XBCC = (bf16*)(ws + WS_XBCC);
    const float* cw = p.in[IN_OCW]; const float* cb = p.in[IN_OCB];
    const int gt = c.gw * 64 + c.lane, NGT = c.NGW * 64;
    for (int idx = gt; idx < (MP / 8) * 384; idx += NGT) {
        const int rg = idx / 384, c8 = idx % 384, row0 = rg * 8, t0 = row0 & (TP - 1), ch = c8 * 8;
        float w[4][8], bias[8];
#pragma unroll
        for (int k = 0; k < 4; ++k) { const f32x4 a = *(const f32x4*)(cw + k * 3072 + ch), d = *(const f32x4*)(cw + k * 3072 + ch + 4); w[k][0] = a.x; w[k][1] = a.y; w[k][2] = a.z; w[k][3] = a.w; w[k][4] = d.x; w[k][5] = d.y; w[k][6] = d.z; w[k][7] = d.w; }
        { const f32x4 a = *(const f32x4*)(cb + ch), d = *(const f32x4*)(cb + ch + 4); bias[0] = a.x; bias[1] = a.y; bias[2] = a.z; bias[3] = a.w; bias[4] = d.x; bias[5] = d.y; bias[6] = d.z; bias[7] = d.w; }
        u32x4 x[11];
#pragma unroll
        for (int i = 0; i < 11; ++i) { x[i] = (u32x4){0u, 0u, 0u, 0u}; if (t0 + i - 3 >= 0) x[i] = *(const u32x4*)(XBC + (size_t)(row0 + i - 3) * 3072 + ch); }
#pragma unroll
        for (int t = 0; t < 8; ++t) { float a[8];
#pragma unroll
            for (int e = 0; e < 8; ++e) a[e] = bias[e];
#pragma unroll
            for (int k = 0; k < 4; ++k) { const u32x4 v = x[t + k]; a[0] = fmaf(w[k][0], bflo(v.x), a[0]); a[1] = fmaf(w[k][1], bfhi(v.x), a[1]); a[2] = fmaf(w[k][2], bflo(v.y), a[2]); a[3] = fmaf(w[k][3], bfhi(v.y), a[3]);
                a[4] = fmaf(w[k][4], bflo(v.z), a[4]); a[5] = fmaf(w[k][5], bfhi(v.z), a[5]); a[6] = fmaf(w[k][6], bflo(v.w), a[6]); a[7] = fmaf(w[k][7], bfhi(v.w), a[7]); }
#pragma unroll
            for (int e = 0; e < 8; ++e) a[e] = siluf_(a[e]);
            store_bf<8>(XBCC + (size_t)(row0 + t) * 3072 + ch, a); }
        if (t0 == TP - 8) { float* o = p.out + O_CCP + (size_t)(row0 >> 11) * 3 * 3072 + ch;
#pragma unroll
            for (int i = 0; i < 3; ++i) { const u32x4 v = x[8 + i]; *(f32x4*)(o + i * 3072) = (f32x4){bflo(v.x), bfhi(v.x), bflo(v.y), bfhi(v.y)}; *(f32x4*)(o + i * 3072 + 4) = (f32x4){bflo(v.z), bfhi(v.z), bflo(v.w), bfhi(v.w)}; } }
    }
    for (int idx = gt; idx < NBS * 384; idx += NGT) {
        const int b = idx / 384, c8 = idx % 384, ch = c8 * 8; const size_t row0 = (size_t)MP + 4 * b;
        float xe[7][8];
#pragma unroll
        for (int i = 0; i < 3; ++i) { const float* s = p.in[IN_SCC] + ((size_t)b * 3 + i) * 3072 + ch; const f32x4 a = *(const f32x4*)s, d = *(const f32x4*)(s + 4); xe[i][0] = a.x; xe[i][1] = a.y; xe[i][2] = a.z; xe[i][3] = a.w; xe[i][4] = d.x; xe[i][5] = d.y; xe[i][6] = d.z; xe[i][7] = d.w; }
#pragma unroll
        for (int i = 0; i < 4; ++i) { const u32x4 v = *(const u32x4*)(XBC + (row0 + i) * 3072 + ch); xe[3 + i][0] = bflo(v.x); xe[3 + i][1] = bfhi(v.x); xe[3 + i][2] = bflo(v.y); xe[3 + i][3] = bfhi(v.y); xe[3 + i][4] = bflo(v.z); xe[3 + i][5] = bfhi(v.z); xe[3 + i][6] = bflo(v.w); xe[3 + i][7] = bfhi(v.w); }
#pragma unroll
        for (int t = 0; t < 4; ++t) { float a[8];
#pragma unroll
            for (int e = 0; e < 8; ++e) { float s = cb[ch + e];
#pragma unroll
                for (int k = 0; k < 4; ++k) s = fmaf(cw[k * 3072 + ch + e], xe[t + k][e], s);
                a[e] = siluf_(s); }
            store_bf<8>(XBCC + (row0 + t) * 3072 + ch, a); }
        float* o = p.out + O_CCS + (size_t)b * 3 * 3072 + ch;
#pragma unroll
        for (int i = 0; i < 3; ++i) { *(f32x4*)(o + i * 3072) = (f32x4){xe[4 + i][0], xe[4 + i][1], xe[4 + i][2], xe[4 + i][3]}; *(f32x4*)(o + i * 3072 + 4) = (f32x4){xe[4 + i][4], xe[4 + i][5], xe[4 + i][6], xe[4 + i][7]}; }
    }
}

constexpr int BSS = 272, XSS = 144;
constexpr int L_BS = 0, L_CS = 128 * 256, L_XS = L_CS + 128 * BSS, L_XD = L_XS + 128 * XSS, L_SB = L_XD + 128 * XSS, L_CUM = L_SB + 64 * BSS, L_DTV = L_CUM + 512, L_YT = L_DTV + 512, L_SSD_END = L_YT + 128 * XSS;
static_assert(L_SSD_END <= MISC_OFF, "ssd lds");
__device__ __forceinline__ int bs_f(int r) { return ((r & 3) << 2) | ((r >> 2) & 3); }
__device__ __forceinline__ void ssd_prompt_unit(const Params& p, const Ctx& c, int b, int hd) {
    unsigned char* ws = p.ws;
    const bf16* XB = (const bf16*)(ws + WS_XBCC); const bf16* ZS = (const bf16*)(ws + WS_ZS); const float* DT = (const float*)(ws + WS_DT); bf16* YZ = (bf16*)(ws + WS_YZ);
    const int tid = c.tid, lane = c.lane, r32 = lane & 31, hi = lane >> 5, w = c.wave, pb = w >> 2, tb = pb ? 3 - (w & 3) : (w & 3), g = hd >> 3;
    const float a_h = -__expf(p.in[IN_OALOG][hd]), d_h = p.in[IN_OD][hd];
    LAS unsigned char* L = c.lds;
    LAS float* CUM = (LAS float*)(L + L_CUM); LAS float* DTV = (LAS float*)(L + L_DTV);
    f32x16 st = {};
    const int trofs = ((lane & 15) >> 2);
    const int trcol = (((lane >> 4) & 1) * 16 + (lane & 3) * 4) * 2;
    u32x4 rb[4], rc[4], rx[2]; float d0 = 0.f, d1 = 0.f;
    const bf16* bbase = XB + (size_t)b * TP * 3072 + 2048 + g * 128; const bf16* xbase = XB + (size_t)b * TP * 3072 + hd * 64;
    const bf16* zbase = ZS + (size_t)b * TP * 2048 + hd * 64; const float* dbase = DT + (size_t)b * TP * 32 + hd;
    const unsigned bo = (unsigned)((tid >> 4) * 3072 + (tid & 15) * 8), xo = (unsigned)((tid >> 3) * 3072 + (tid & 7) * 8), zo = (unsigned)((tid >> 3) * 2048 + (tid & 7) * 8), dof = (unsigned)(2 * lane * 32);
#define SSD_LOAD(ck_) do { const bf16* bb_ = bbase + (size_t)(128 * (ck_)) * 3072; const bf16* xb_ = xbase + (size_t)(128 * (ck_)) * 3072; \
        _Pragma("unroll") for (int i_ = 0; i_ < 4; ++i_) { rb[i_] = *(const u32x4*)(bb_ + (size_t)i_ * 32 * 3072 + bo); rc[i_] = *(const u32x4*)(bb_ + (size_t)i_ * 32 * 3072 + 512 + bo); } \
        _Pragma("unroll") for (int i_ = 0; i_ < 2; ++i_) rx[i_] = *(const u32x4*)(xb_ + (size_t)i_ * 64 * 3072 + xo); \
        if (w == 0) { const float* db_ = dbase + (size_t)(128 * (ck_)) * 32; d0 = db_[dof]; d1 = db_[dof + 32]; } } while (0)
    SSD_LOAD(0);
    const int lbc = (tid >> 4) * BSS + (tid & 15) * 16, lx = (tid >> 3) * XSS + (tid & 7) * 16;
    const int lbs = (tid >> 4) * 256 + 16 * ((tid & 15) ^ bs_f(tid >> 4));
    const int fs_row = bs_f(r32);
    const int f_lo = (trofs << 2) | (2 * hi), f_hi = (trofs << 2) | (2 * hi + 1);
#pragma unroll 1
    for (int ck = 0; ck < 16; ++ck) {
        asm volatile("; SSD_CHUNK_BEGIN");
        const size_t row0 = (size_t)b * TP + 128 * ck;
        __syncthreads();
        if (w == 0) { const float v0 = a_h * LOG2E * d0, v1 = a_h * LOG2E * d1; float s = v0 + v1;
#pragma unroll
            for (int o = 1; o < 64; o <<= 1) { const float t = __shfl_up(s, o); if (lane >= o) s += t; }
            CUM[2 * lane] = s - v1; CUM[2 * lane + 1] = s; DTV[2 * lane] = (s - v1) - __builtin_amdgcn_logf(d0); DTV[2 * lane + 1] = s - __builtin_amdgcn_logf(d1); }
#pragma unroll
        for (int i = 0; i < 4; ++i) { *(LAS u32x4*)(L + L_BS + lbs + i * 32 * 256) = rb[i]; *(LAS u32x4*)(L + L_CS + lbc + i * 32 * BSS) = rc[i]; }
#pragma unroll
        for (int i = 0; i < 2; ++i) *(LAS u32x4*)(L + L_XS + lx + i * 64 * XSS) = rx[i];
#pragma unroll
        for (int r = 0; r < 16; ++r) *(LAS unsigned short*)(L + L_SB + (32 * pb + crow(r, hi)) * BSS + (32 * tb + r32) * 2) = (unsigned short)f2bf(st[r]);
        __syncthreads();
        const float cum_last = CUM[127];
#pragma unroll
        for (int i = 0; i < 2; ++i) { const int row = (tid >> 3) + 64 * i; const u32x4 v = rx[i]; const float te = EXP2(cum_last - DTV[row]);
            *(LAS u32x4*)(L + L_XD + lx + i * 64 * XSS) = (u32x4){pk2(bflo(v.x) * te, bfhi(v.x) * te), pk2(bflo(v.y) * te, bfhi(v.y) * te), pk2(bflo(v.z) * te, bfhi(v.z) * te), pk2(bflo(v.w) * te, bfhi(v.w) * te)}; }
        if (ck < 15) SSD_LOAD(ck + 1);
        const int t = 32 * tb + r32; const float cum_t = CUM[t];
        bf16x8 cf[8];
#pragma unroll
        for (int kn = 0; kn < 8; ++kn) cf[kn] = *(const LAS bf16x8*)(L + L_CS + t * BSS + (16 * kn + 8 * hi) * 2);
        SCHED_FENCE();
        f32x16 y = {};
        { bf16x8 sf[8];
#pragma unroll
          for (int kn = 0; kn < 8; ++kn) sf[kn] = *(const LAS bf16x8*)(L + L_SB + (32 * pb + r32) * BSS + (16 * kn + 8 * hi) * 2);
          SCHED_FENCE();
#pragma unroll
          for (int kn = 0; kn < 8; ++kn) y = mfma32(sf[kn], cf[kn], y);
          SCHED_FENCE(); }
        y *= EXP2(cum_t);
#define SSD_CB(xd_, sb_) do { xd_ = (f32x16){}; \
            _Pragma("unroll") for (int k4 = 0; k4 < 2; ++k4) { bf16x8 bfr[4]; \
                _Pragma("unroll") for (int kn = 0; kn < 4; ++kn) bfr[kn] = *(const LAS bf16x8*)(L + L_BS + (32 * (sb_) + r32) * 256 + 16 * ((2 * (4 * k4 + kn) + hi) ^ fs_row)); \
                SCHED_FENCE(); \
                _Pragma("unroll") for (int kn = 0; kn < 4; ++kn) xd_ = mfma32(bfr[kn], cf[4 * k4 + kn], xd_); \
                SCHED_FENCE(); } } while (0)
        f32x16 x; SSD_CB(x, 0);
#pragma unroll 1
        for (int sb = 0; sb <= tb; ++sb) {
            f32x16 xn; { const int sn = sb < tb ? sb + 1 : tb; SSD_CB(xn, sn); }
            const LAS unsigned char* xa = L + L_XS + (32 * sb + 4 * hi + trofs) * XSS + pb * 64 + trcol;
            const s16x4 t0 = tr_read(xa), t1 = tr_read(xa + 8 * XSS), t2 = tr_read(xa + 16 * XSS), t3 = tr_read(xa + 24 * XSS);
            { f32x4 ev[4];
#pragma unroll
              for (int g4 = 0; g4 < 4; ++g4) ev[g4] = *(const LAS f32x4*)(DTV + 32 * sb + 8 * g4 + 4 * hi);
              if (sb == tb) {
#pragma unroll
                for (int r = 0; r < 16; ++r) { const float wv = x[r] * EXP2(cum_t - ev[r >> 2][r & 3]); x[r] = (crow(r, hi) <= r32) ? wv : 0.f; }
              } else {
#pragma unroll
                for (int r = 0; r < 16; ++r) x[r] *= EXP2(cum_t - ev[r >> 2][r & 3]);
              } }
            const bf16x8 wf0 = pack8(x[0], x[1], x[2], x[3], x[4], x[5], x[6], x[7]), wf1 = pack8(x[8], x[9], x[10], x[11], x[12], x[13], x[14], x[15]);
            y = mfma32(cat4(t0, t1), wf0, y); y = mfma32(cat4(t2, t3), wf1, y);
            x = xn;
        }
        {
#pragma unroll
            for (int g4 = 0; g4 < 4; ++g4) { const int p0 = 32 * pb + 8 * g4 + 4 * hi; const u32x2 xv = *(const LAS u32x2*)(L + L_XS + t * XSS + p0 * 2);
                u32x2 o; o.x = pk2(y[4 * g4] + d_h * bflo(xv.x), y[4 * g4 + 1] + d_h * bfhi(xv.x)); o.y = pk2(y[4 * g4 + 2] + d_h * bflo(xv.y), y[4 * g4 + 3] + d_h * bfhi(xv.y));
                *(LAS u32x2*)(L + L_YT + t * XSS + p0 * 2) = o; }
        }
        asm volatile("s_waitcnt lgkmcnt(0)\n\ts_barrier" ::: "memory");
        const bf16* zb_ = zbase + (size_t)(128 * ck) * 2048; const u32x4 zc0 = *(const u32x4*)(zb_ + zo), zc1 = *(const u32x4*)(zb_ + (size_t)64 * 2048 + zo);
        st *= EXP2(cum_last);
        { const LAS unsigned char* xa = L + L_XD + (8 * hi + trofs) * XSS + pb * 64 + trcol;
          const int bch = 4 * tb + 2 * ((lane >> 4) & 1) + ((lane & 3) >> 1), bsub = 8 * (lane & 1);
          const LAS unsigned char* ba_lo = L + L_BS + (8 * hi + trofs) * 256 + 16 * (bch ^ f_lo) + bsub; const LAS unsigned char* ba_hi = L + L_BS + (8 * hi + trofs + 4) * 256 + 16 * (bch ^ f_hi) + bsub;
#pragma unroll
          for (int k4 = 0; k4 < 2; ++k4) { s16x4 ta[4], tb2[4], tc[4], td[4];
#pragma unroll
              for (int j = 0; j < 4; ++j) { const int ks = 4 * k4 + j; ta[j] = tr_read(xa + (16 * ks) * XSS); tb2[j] = tr_read(xa + (16 * ks + 4) * XSS); tc[j] = tr_read(ba_lo + (16 * ks) * 256); td[j] = tr_read(ba_hi + (16 * ks) * 256); }
              SCHED_FENCE();
#pragma unroll
              for (int j = 0; j < 4; ++j) st = mfma32(cat4(ta[j], tb2[j]), cat4(tc[j], td[j]), st);
              SCHED_FENCE(); } }
#pragma unroll
        for (int i = 0; i < 2; ++i) { const int row = (tid >> 3) + 64 * i; const u32x4 yv = *(const LAS u32x4*)(L + L_YT + lx + i * 64 * XSS); const size_t ga = (row0 + row) * 2048 + hd * 64 + (tid & 7) * 8; const u32x4 zv = i ? zc1 : zc0;
            const float o[8] = {bflo(yv.x) * bflo(zv.x), bfhi(yv.x) * bfhi(zv.x), bflo(yv.y) * bflo(zv.y), bfhi(yv.y) * bfhi(zv.y), bflo(yv.z) * bflo(zv.z), bfhi(yv.z) * bfhi(zv.z), bflo(yv.w) * bflo(zv.w), bfhi(yv.w) * bfhi(zv.w)};
            store_bf<8>(YZ + ga, o); }
        asm volatile("; SSD_CHUNK_END");
    }
    { unsigned so_off = (unsigned)((32 * pb + 4 * hi) * 128 + 32 * tb + r32); asm volatile("" : "+v"(so_off));
      float* so = p.out + O_SSMP + ((size_t)(b * 32 + hd) * 64) * 128 + so_off;
#pragma unroll
      for (int r = 0; r < 16; ++r) so[((r & 3) + 8 * (r >> 2)) * 128] = st[r]; }
    __syncthreads();
}
__device__ __forceinline__ void ssd_sample_unit(const Params& p, const Ctx& c, int b, int hd, const f32x4 (&sin)[4]) {
    unsigned char* ws = p.ws;
    const bf16* XB = (const bf16*)(ws + WS_XBCC); const bf16* ZS = (const bf16*)(ws + WS_ZS); const float* DT = (const float*)(ws + WS_DT); bf16* YZ = (bf16*)(ws + WS_YZ);
    const int tid = c.tid, pp = tid >> 3, n0 = (tid & 7) * 16, g = hd >> 3;
    const float a_h = -__expf(p.in[IN_OALOG][hd]), d_h = p.in[IN_OD][hd];
    float st[16];
#pragma unroll
    for (int i = 0; i < 4; ++i) { const f32x4 v = sin[i]; st[4 * i] = v.x; st[4 * i + 1] = v.y; st[4 * i + 2] = v.z; st[4 * i + 3] = v.w; }
#pragma unroll
    for (int t = 0; t < 4; ++t) { const size_t row = (size_t)MP + 4 * b + t; const float dt = DT[row * 32 + hd], dA = __expf(dt * a_h);
        const float xv = bf2f(XB[row * 3072 + hd * 64 + pp]);
        const u32x4 b0 = *(const u32x4*)(XB + row * 3072 + 2048 + g * 128 + n0), b1 = *(const u32x4*)(XB + row * 3072 + 2048 + g * 128 + n0 + 8);
        const u32x4 c0 = *(const u32x4*)(XB + row * 3072 + 2560 + g * 128 + n0), c1 = *(const u32x4*)(XB + row * 3072 + 2560 + g * 128 + n0 + 8);
        const float bv[16] = {bflo(b0.x), bfhi(b0.x), bflo(b0.y), bfhi(b0.y), bflo(b0.z), bfhi(b0.z), bflo(b0.w), bfhi(b0.w), bflo(b1.x), bfhi(b1.x), bflo(b1.y), bfhi(b1.y), bflo(b1.z), bfhi(b1.z), bflo(b1.w), bfhi(b1.w)};
        const float cv[16] = {bflo(c0.x), bfhi(c0.x), bflo(c0.y), bfhi(c0.y), bflo(c0.z), bfhi(c0.z), bflo(c0.w), bfhi(c0.w), bflo(c1.x), bfhi(c1.x), bflo(c1.y), bfhi(c1.y), bflo(c1.z), bfhi(c1.z), bflo(c1.w), bfhi(c1.w)};
        const float xdt = xv * dt; float y = 0.f;
#pragma unroll
        for (int i = 0; i < 16; ++i) { st[i] = fmaf(st[i], dA, xdt * bv[i]); y = fmaf(st[i], cv[i], y); }
        y += __shfl_xor(y, 1); y += __shfl_xor(y, 2); y += __shfl_xor(y, 4);
        if ((tid & 7) == 0) { const float z = bf2f(ZS[row * 2048 + hd * 64 + pp]); YZ[row * 2048 + hd * 64 + pp] = (bf16)f2bf((y + d_h * xv) * z); }
    }
    float* so = p.out + O_SSMS + (((size_t)b * 32 + hd) * 64 + pp) * 128 + n0;
#pragma unroll
    for (int i = 0; i < 4; ++i) __builtin_nontemporal_store((f32x4){st[4 * i], st[4 * i + 1], st[4 * i + 2], st[4 * i + 3]}, (f32x4*)(so + 4 * i));
}
__device__ __forceinline__ void phase_ssd(const Params& p, const Ctx& c) {
#ifndef REPSUB
#define REPSUB 0
#endif
#pragma unroll 1
    for (int rep = 0; rep < 1 + (REPSUB & 1); ++rep)
    { const int vcu = (c.G % 8 == 0) ? (c.cu & 7) * (c.G >> 3) + (c.cu >> 3) : c.cu;
      for (int u = vcu; u < 256; u += c.G) ssd_prompt_unit(p, c, u >> 5, u & 31); }
#pragma unroll 1
    for (int rep = 0; rep < 1 + ((REPSUB >> 1) & 1); ++rep)
    {
        const int tid = c.tid; const float* sbase = p.in[IN_SSM] + (size_t)(tid >> 3) * 128 + (tid & 7) * 16;
        f32x4 nx[4];
        if (c.cu < 1024) {
#pragma unroll
            for (int i = 0; i < 4; ++i) nx[i] = ldnt4(sbase + (size_t)c.cu * 64 * 128 + 4 * i); }
#pragma unroll 1
        for (int u = c.cu; u < 1024; u += c.G) {
            f32x4 cur[4];
#pragma unroll
            for (int i = 0; i < 4; ++i) cur[i] = nx[i];
            if (u + c.G < 1024) {
#pragma unroll
                for (int i = 0; i < 4; ++i) nx[i] = ldnt4(sbase + (size_t)(u + c.G) * 64 * 128 + 4 * i); }
            ssd_sample_unit(p, c, u >> 5, u & 31, cur);
        }
    }
}
__device__ __forceinline__ void phase_gnorm(const Params& p, const Ctx& c) {
    unsigned char* ws = p.ws; const bf16* YZ = (const bf16*)(ws + WS_YZ); bf16* YN = (bf16*)(ws + WS_YN); const float* nw = p.in[IN_ONORM];
    for (int r = c.gw; r < MT; r += c.NGW) {
#pragma unroll
        for (int j = 0; j < 4; ++j) { const int e0 = 8 * (c.lane + 64 * j); const u32x4 v = *(const u32x4*)(YZ + (size_t)r * 2048 + e0);
            const float x[8] = {bflo(v.x), bfhi(v.x), bflo(v.y), bfhi(v.y), bflo(v.z), bfhi(v.z), bflo(v.w), bfhi(v.w)};
            float s = 0.f;
#pragma unroll
            for (int e = 0; e < 8; ++e) s += x[e] * x[e];
            const float rr = rsqrtf(wave_sum(s) * (1.f / 512.f) + EPS); const f32x4 w0 = *(const f32x4*)(nw + e0), w1 = *(const f32x4*)(nw + e0 + 4);
            const float o[8] = {x[0] * rr * w0.x, x[1] * rr * w0.y, x[2] * rr * w0.z, x[3] * rr * w0.w, x[4] * rr * w1.x, x[5] * rr * w1.y, x[6] * rr * w1.z, x[7] * rr * w1.w};
            store_bf<8>(YN + (size_t)r * 2048 + e0, o); }
    }
}
constexpr int NPHASE = 22;
template <class F> __device__ __forceinline__ void run_gemm(const Ctx& c, const bf16* A, const bf16* Bt, int M, int N, int K, int cu_eff, const F& f) {
    pg8::Gemm g{A, Bt, M, N, K}; pg8::StaticOrder S; S.init(M, N, c.G, cu_eff);
    Epi8<F> E{f};
    pg8::gemm_phase<Epi8<F>, pg8::StaticOrder, true, true>((PG8_LAS unsigned char*)c.lds, g, S, E, c.tid);
}
__global__ void __launch_bounds__(512, 2) mega_fwd(Params p) {
    extern __shared__ __attribute__((aligned(16))) unsigned char lds_raw[];
    LAS unsigned char* const lds0 = (LAS unsigned char*)lds_raw;
    const int wave0 = __builtin_amdgcn_readfirstlane((int)threadIdx.x >> 6);
#define MKCTX() Ctx c; { int l_; asm volatile("v_mbcnt_lo_u32_b32 %0, -1, 0\n\tv_mbcnt_hi_u32_b32 %0, -1, %0" : "=v"(l_)); c.lds = lds0; c.lane = l_; c.wave = wave0; c.tid = wave0 * 64 + l_; \
        c.G = gridDim.x; c.cu = blockIdx.x; c.gw = c.cu * 8 + c.wave; c.NGW = c.G * 8; }
    unsigned char* ws = p.ws;
    volatile LAS unsigned* MISC = (volatile LAS unsigned*)(lds0 + MISC_OFF);
    { MKCTX(); for (int u = c.tid; u < (LDS_BYTES - RING_BYTES) / 4; u += 512) ((LAS unsigned*)(lds0 + RING_BYTES))[u] = 0u; }
    __syncthreads();
    const int lo = p.ph_lo, hi = p.ph_hi;
    const bool multi = (hi - lo) > 1;
    XcdBarrier bar; bar.bar = (unsigned*)(ws + WS_CTL) + CW_BAR; bar.x = 0; bar.st = nullptr;
    if (multi) { MKCTX(); bar = xcd_barrier_post((unsigned*)(ws + WS_CTL) + CW_BAR, MISC + 8, c.tid); }
#ifndef PHMASK
#define PHMASK 0x3fffff
#endif
#define IN(k) ((((PHMASK) >> (k)) & 1) && lo <= (k) && (k) < hi)
#ifndef REPMASK
#define REPMASK 0
#endif
#define NREP(k) (1 + (((REPMASK) >> (k)) & 1))
#define REPBAR(r) do { if (r) { MKCTX(); xcd_barrier(bar, c.tid); } } while (0)
#define SEAM(k) do { if (IN(k) && IN((k) + 1)) { MKCTX(); xcd_barrier(bar, c.tid); } } while (0)
    bf16* H = (bf16*)(ws + WS_H); bf16* YB = (bf16*)(ws + WS_YB); bf16* YCAT = (bf16*)(ws + WS_YCAT);

    if (IN(0)) _Pragma("unroll") for (int rep_ = 0; rep_ < NREP(0); ++rep_) { REPBAR(rep_); MKCTX(); phase_prep(p, c); } SEAM(0);
    if (IN(1)) _Pragma("unroll") for (int rep_ = 0; rep_ < NREP(1); ++rep_) { REPBAR(rep_); MKCTX();
        FGemm1 f{(bf16*)(ws + WS_GLU), (bf16*)(ws + WS_GATE), (bf16*)(ws + WS_CQ), (bf16*)(ws + WS_KVRAW)};
        run_gemm(c, H, (const bf16*)(ws + WS_WEIN), MP, 2560, 1024, c.cu, f);
#pragma unroll 1
        for (int i = 0; i < 2; ++i) { FMemKV fm{p.out + O_MK + (size_t)i * 2048 * 1024, p.out + O_MV + (size_t)i * 2048 * 1024, (bf16*)(ws + WS_MKV) + (size_t)(2 * i) * 2048 * 1024, (bf16*)(ws + WS_MKV) + (size_t)(2 * i + 1) * 2048 * 1024};
            run_gemm(c, (const bf16*)(ws + WS_MN) + (size_t)i * 2048 * 1024, (const bf16*)(ws + WS_WMKV) + (size_t)i * 2048 * 1024, 2048, 2048, 1024, (c.cu + c.G - c.G / 2 - i * (c.G / 4)) % c.G, fm); }
        skinny_sample(c, H, 1024, (const bf16*)(ws + WS_WEIN), 1024, 1024, 2560, f, 0);
    } SEAM(1);
    if (IN(2)) _Pragma("unroll") for (int rep_ = 0; rep_ < NREP(2); ++rep_) { REPBAR(rep_); MKCTX(); phase_conv(p, c); } SEAM(2);
    if (IN(3)) _Pragma("unroll") for (int rep_ = 0; rep_ < NREP(3); ++rep_) { REPBAR(rep_); MKCTX();
        FQ f{(bf16*)(ws + WS_QP), (const float*)(ws + WS_ROPE)};
        run_gemm(c, (const bf16*)(ws + WS_CQN), (const bf16*)(ws + WS_WQ), MP, 1280, 256, c.cu, f);
        skinny_sample(c, (const bf16*)(ws + WS_CQN), 256, (const bf16*)(ws + WS_WQ), 256, 256, 1280, f, 64);
    } SEAM(3);
    if (IN(4)) _Pragma("unroll") for (int rep_ = 0; rep_ < NREP(4); ++rep_) { REPBAR(rep_); MKCTX(); phase_mla(p, c); } SEAM(4);
    if (IN(5)) _Pragma("unroll") for (int rep_ = 0; rep_ < NREP(5); ++rep_) { REPBAR(rep_); MKCTX(); for (int b = c.cu; b < NBS; b += c.G) mla_combine_unit(p, c, b); } SEAM(5);
    if (IN(6)) _Pragma("unroll") for (int rep_ = 0; rep_ < NREP(6); ++rep_) { REPBAR(rep_); MKCTX();
        FPlain f{YB, 1024};
        run_gemm(c, YCAT, (const bf16*)(ws + WS_WEOUT), MP, 1024, 1024, c.cu, f);
        skinny_sample(c, YCAT, 1024, (const bf16*)(ws + WS_WEOUT), 1024, 1024, 1024, f, 0);
    } SEAM(6);
    if (IN(7)) _Pragma("unroll") for (int rep_ = 0; rep_ < NREP(7); ++rep_) { REPBAR(rep_); MKCTX(); phase_resid<0>(p, c, p.in[IN_NQM], p.in[IN_NPX]); } SEAM(7);
#define CROSS_PHASES(layer, pb) do { \
        if (IN(pb)) _Pragma("unroll") for (int rep_ = 0; rep_ < NREP(pb); ++rep_) { REPBAR(rep_); MKCTX(); FQG f{(bf16*)(ws + WS_XQ), (bf16*)(ws + WS_XG)}; \
            run_gemm(c, H, (const bf16*)(ws + WS_WQG) + (size_t)(layer) * 2048 * 1024, MP, 2048, 1024, c.cu, f); \
            skinny_sample(c, H, 1024, (const bf16*)(ws + WS_WQG) + (size_t)(layer) * 2048 * 1024, 1024, 1024, 2048, f, 0); } SEAM(pb); \
        if (IN((pb) + 1)) _Pragma("unroll") for (int rep_ = 0; rep_ < NREP((pb) + 1); ++rep_) { REPBAR(rep_); MKCTX(); phase_xattn(p, c, layer); } SEAM((pb) + 1); \
        if (IN((pb) + 2)) _Pragma("unroll") for (int rep_ = 0; rep_ < NREP((pb) + 2); ++rep_) { REPBAR(rep_); MKCTX(); FPlain f{YB, 1024}; \
            run_gemm(c, (const bf16*)(ws + WS_XO), (const bf16*)(ws + WS_WXO) + (size_t)(layer) * 1024 * 1024, MP, 1024, 1024, c.cu, f); \
            skinny_sample(c, (const bf16*)(ws + WS_XO), 1024, (const bf16*)(ws + WS_WXO) + (size_t)(layer) * 1024 * 1024, 1024, 1024, 1024, f, 0); } SEAM((pb) + 2); \
        if (IN((pb) + 3)) _Pragma("unroll") for (int rep_ = 0; rep_ < NREP((pb) + 3); ++rep_) { REPBAR(rep_); MKCTX(); if ((layer) == 0) phase_resid<1>(p, c, p.in[IN_NQX], p.in[IN_NPM] + DM); else phase_resid<2>(p, c, p.in[IN_NQX] + DM, nullptr); } SEAM((pb) + 3); \
    } while (0)
    CROSS_PHASES(0, 8);
    if (IN(12)) _Pragma("unroll") for (int rep_ = 0; rep_ < NREP(12); ++rep_) { REPBAR(rep_); MKCTX();
        FOIn f{(bf16*)(ws + WS_ZS), (bf16*)(ws + WS_XBC)};
        run_gemm(c, H, (const bf16*)(ws + WS_WOIN), MP, 5120, 1024, c.cu, f);
        skinny_sample(c, H, 1024, (const bf16*)(ws + WS_WOIN), 1024, 1024, 5120, f, 0);
        FDt fd{(float*)(ws + WS_DT), p.in[IN_ODTB]};
        for (int u = (c.cu + c.G - 160 % c.G) % c.G; u < MT / 64; u += c.G) { const bf16* Bu = (const bf16*)(ws + WS_WDT); asm volatile("" : "+s"(Bu)); skinny_unit(c, H, 1024, Bu, 1024, 1024, 64 * u, 0, 64 * u + 32, 0, fd); }
    } SEAM(12);
    if (IN(13)) _Pragma("unroll") for (int rep_ = 0; rep_ < NREP(13); ++rep_) { REPBAR(rep_); MKCTX(); phase_conv4(p, c); } SEAM(13);
    if (IN(14)) _Pragma("unroll") for (int rep_ = 0; rep_ < NREP(14); ++rep_) { REPBAR(rep_); MKCTX(); phase_ssd(p, c); } SEAM(14);
    if (IN(15)) _Pragma("unroll") for (int rep_ = 0; rep_ < NREP(15); ++rep_) { REPBAR(rep_); MKCTX(); phase_gnorm(p, c); } SEAM(15);
    if (IN(16)) _Pragma("unroll") for (int rep_ = 0; rep_ < NREP(16); ++rep_) { REPBAR(rep_); MKCTX();
        FPlain f{YB, 1024};
        run_gemm(c, (const bf16*)(ws + WS_YN), (const bf16*)(ws + WS_WOOUT), MP, 1024, 2048, c.cu, f);
        skinny_sample(c, (const bf16*)(ws + WS_YN), 2048, (const bf16*)(ws + WS_WOOUT), 2048, 2048, 1024, f, 0);
    } SEAM(16);
    if (IN(17)) _Pragma("unroll") for (int rep_ = 0; rep_ < NREP(17); ++rep_) { REPBAR(rep_); MKCTX(); phase_resid<1>(p, c, p.in[IN_NQM] + DM, p.in[IN_NPX] + DM); } SEAM(17);
    CROSS_PHASES(1, 18);
#undef IN
#undef SEAM
}

extern "C" void kernel_launch(void* const* d_in, const int* in_sizes, int n_in, void* d_out, int out_size, void* d_ws, size_t ws_size, hipStream_t stream) {
    static int grid = 0;
    if (grid == 0) {
        if (n_in != 39 || (size_t)out_size != O_END || ws_size < WS_END) { fprintf(stderr, "kernel_launch: unexpected shapes: n_in %d out %d ws %zu (need %zu)\n", n_in, out_size, ws_size, (size_t)WS_END); grid = -1; return; }
        int dev = 0, cus = 0, per_cu = 0;
        if (hipGetDevice(&dev) != hipSuccess || hipDeviceGetAttribute(&cus, hipDeviceAttributeMultiprocessorCount, dev) != hipSuccess) { grid = -1; return; }
        if (hipFuncSetAttribute((const void*)mega_fwd, hipFuncAttributeMaxDynamicSharedMemorySize, LDS_BYTES) != hipSuccess) { fprintf(stderr, "kernel_launch: hipFuncSetAttribute failed\n"); grid = -1; return; }
        if (hipOccupancyMaxActiveBlocksPerMultiprocessor(&per_cu, (const void*)mega_fwd, 512, LDS_BYTES) != hipSuccess || per_cu < 1) { fprintf(stderr, "kernel_launch: occupancy query says %d blocks per CU\n", per_cu); per_cu = 1; }
        (void)hipGetLastError();
        grid = cus;
    }
    if (grid < 0) return;
    (void)hipMemsetAsync((char*)d_ws + WS_CTL + (size_t)CW_BAR * 4, 0, (size_t)XCD_BAR_WORDS * 4, stream);
    Params a{};
    for (int i = 0; i < 39; ++i) a.in[i] = (const float*)d_in[i];
    a.out = (float*)d_out; a.ws = (unsigned char*)d_ws;
#ifndef MK_ONE_LAUNCH
#define MK_ONE_LAUNCH 1
#endif
    if (MK_ONE_LAUNCH) { a.ph_lo = 0; a.ph_hi = NPHASE; hipLaunchKernelGGL(mega_fwd, dim3(grid), dim3(512), LDS_BYTES, stream, a); }
    else for (int ph = 0; ph < NPHASE; ++ph) { a.ph_lo = ph; a.ph_hi = ph + 1; hipLaunchKernelGGL(mega_fwd, dim3(grid), dim3(512), LDS_BYTES, stream, a); }
}
```

```cpp
#include <hip/hip_runtime.h>
#include <cstdio>
#include <cstdint>
namespace pg8 {
#define PG8_LAS __attribute__((address_space(3)))
typedef unsigned short bf16_t;
typedef short bf16x8 __attribute__((ext_vector_type(8)));
typedef float f32x4 __attribute__((ext_vector_type(4)));
typedef unsigned u32x4 __attribute__((ext_vector_type(4)));
constexpr int BM = 256, BK = 64, HALF = 128, HTB = HALF * BK * 2  , STAGE_BYTES = 8 * HTB, NXCD = 8, WGM = 8;

__host__ __device__ __forceinline__ int lds_byte(int r, int c) { const int st = (r >> 4) * 2 + (c >> 5), rr = r & 15, cc = c & 31, ob = rr * 64 + cc * 2; return st * 1024 + (ob ^ (((ob >> 9) & 1) << 5)); }
__host__ __device__ __forceinline__ void stage_rc(int b, int& R, int& C) { const int st = b / 1024, sb = b % 1024, swz = sb ^ (((sb >> 9) & 1) << 5); R = (st >> 1) * 16 + swz / 64; C = (st & 1) * 32 + (swz % 64) / 2; }
__host__ __device__ __forceinline__ int perm32(int rho) { const int n = rho >> 4, i = rho & 15; return 8 * (i >> 2) + 4 * n + (i & 3); }

struct Unit { int pm, pn; };
struct Gemm { const bf16_t* A; const bf16_t* Bt; int M, N, K; };

struct StaticOrder {
    int nM, nN, nwg, G, c;
    __host__ __device__ void init(int M, int N, int G_, int c_) { nM = M / BM; nN = N / BM; nwg = nM * nN; G = G_; c = c_; }
    __host__ __device__ bool next(int i, Unit& u) const {
        const long L = (long)i * G + c; if (L >= nwg) return false;
        int wgid = (int)L; { const int q = nwg / NXCD, r = nwg % NXCD, xcd = wgid % NXCD, off = wgid / NXCD; wgid = (xcd < r ? xcd * (q + 1) : r * (q + 1) + (xcd - r) * q) + off; }
        const int nig = WGM * nN, gid = wgid / nig, fm = gid * WGM, gsz = (nM - fm) < WGM ? (nM - fm) : WGM;
        u.pm = fm + ((wgid % nig) % gsz); u.pn = (wgid % nig) / gsz; return true;
    }
    __device__ __forceinline__ void a_ready(const Unit&) const {}
    __device__ __forceinline__ void done(const Unit&) const {}
};
template <class Epi, class Sched, bool ALIGN_EPI = false, bool SP2 = false>
__device__ __forceinline__ void gemm_phase(PG8_LAS unsigned char* lds, const Gemm g, const Sched& S, const Epi& E, const int tid_in) {
    const int tid = tid_in, wid = __builtin_amdgcn_readfirstlane(tid >> 6), lane = tid & 63, wr = wid >> 2, wc = wid & 3, fr = lane & 15, fq = lane >> 4;
    const int K = g.K, nt = K / BK;
    unsigned voffA[2], voffB[2];
#pragma unroll
    for (int i = 0; i < 2; ++i) { int R, C; stage_rc(tid * 16 + i * 8192, R, C); const int Rb = Epi::PERM ? ((R & ~31) + perm32(R & 31)) : R;
        voffA[i] = (unsigned)(R * K + C) * 2u; voffB[i] = (unsigned)(Rb * K + C) * 2u; }
    const size_t kstep = (size_t)(BK * 2);
    const size_t hstep = (size_t)HALF * K * 2;
    const size_t tstep = 2 * hstep;
    const unsigned ldsw = (unsigned)wid * 1024u;
    const int aoff = lds_byte(wr * 64 + fr, fq * 8), boff = lds_byte(wc * 32 + fr, fq * 8);
#define PG8_SA(b, h) (((b) * 2 + (h)) * HTB)
#define PG8_SB(b, h) ((4 + (b) * 2 + (h)) * HTB)
#define PG8_STAGE(bufoff, gbase, voff) do { _Pragma("unroll") for (int _i = 0; _i < 2; ++_i) \
        __builtin_amdgcn_global_load_lds((const unsigned*)((const char*)(gbase) + (voff)[_i]), (PG8_LAS unsigned*)(lds + (bufoff) + ldsw + _i * 8192), 16, 0, 0); } while (0)
#define PG8_LDA(dst, b, h) do { _Pragma("unroll") for (int m = 0; m < 4; ++m) _Pragma("unroll") for (int k = 0; k < 2; ++k) dst[m][k] = *(const PG8_LAS bf16x8*)(lds + PG8_SA(b, h) + aoff + m * 2048 + k * 1024); } while (0)
#define PG8_LDB(dst, b, h) do { _Pragma("unroll") for (int n = 0; n < 2; ++n) _Pragma("unroll") for (int k = 0; k < 2; ++k) dst[n][k] = *(const PG8_LAS bf16x8*)(lds + PG8_SB(b, h) + boff + n * 2048 + k * 1024); } while (0)
#define PG8_MMA(ai, bj, At, Bt) do { __builtin_amdgcn_s_setprio(1); _Pragma("unroll") for (int m = 0; m < 4; ++m) _Pragma("unroll") for (int n = 0; n < 2; ++n) _Pragma("unroll") for (int k = 0; k < 2; ++k) \
        acc[ai][bj][m][n] = __builtin_amdgcn_mfma_f32_16x16x32_bf16(Bt[n][k], At[m][k], acc[ai][bj][m][n], 0, 0, 0); __builtin_amdgcn_s_setprio(0); } while (0)
#define PG8_WAIT_V(n) asm volatile("s_waitcnt vmcnt(" #n ")" ::: "memory")
#define PG8_WAIT_L(n) asm volatile("s_waitcnt lgkmcnt(" #n ")" ::: "memory")
#define PG8_BAR __builtin_amdgcn_s_barrier()
#define PG8_SCHED __builtin_amdgcn_sched_barrier(0)
    Unit cur, nxt; int ui = 0;
    if (!S.next(0, cur)) return;
    f32x4 acc[2][2][4][2];
#pragma unroll
    for (int a = 0; a < 2; ++a)
#pragma unroll
        for (int b = 0; b < 2; ++b)
#pragma unroll
            for (int m = 0; m < 4; ++m)
#pragma unroll
                for (int n = 0; n < 2; ++n) acc[a][b][m][n] = (f32x4){0.f, 0.f, 0.f, 0.f};
    bf16x8 At[4][2], B0[2][2], B1[2][2];
    const char* cA = (const char*)g.A + (size_t)cur.pm * tstep; const char* cB = (const char*)g.Bt + (size_t)cur.pn * tstep;
    S.a_ready(cur);
    if constexpr (Epi::KGROUP) E.unit_begin(cur, lds, wr, fr);
    if constexpr (SP2) {
        PG8_STAGE(PG8_SB(0, 0), cB, voffB); PG8_STAGE(PG8_SB(0, 1), cB + hstep, voffB); PG8_STAGE(PG8_SA(0, 0), cA, voffA); PG8_STAGE(PG8_SA(0, 1), cA + hstep, voffA);
        if (wr == 1) PG8_BAR;
        PG8_WAIT_V(2); PG8_BAR;
        PG8_STAGE(PG8_SB(1, 0), cB + kstep, voffB); PG8_STAGE(PG8_SA(1, 0), cA + kstep, voffA); PG8_STAGE(PG8_SB(1, 1), cB + hstep + kstep, voffB);
        PG8_WAIT_V(6); PG8_BAR;
    } else {
        PG8_STAGE(PG8_SB(0, 0), cB, voffB); PG8_STAGE(PG8_SA(0, 0), cA, voffA); PG8_STAGE(PG8_SB(0, 1), cB + hstep, voffB); PG8_STAGE(PG8_SA(0, 1), cA + hstep, voffA);
        if (wr == 1) PG8_BAR;
        PG8_WAIT_V(4); PG8_BAR;
        PG8_STAGE(PG8_SB(1, 0), cB + kstep, voffB); PG8_STAGE(PG8_SA(1, 0), cA + kstep, voffA); PG8_STAGE(PG8_SB(1, 1), cB + hstep + kstep, voffB);
        PG8_WAIT_V(6); PG8_BAR;
    }
    for (;;) {
        const bool has_next = S.next(ui + 1, nxt);
        const char* nA = has_next ? (const char*)g.A + (size_t)nxt.pm * tstep : cA; const char* nB = has_next ? (const char*)g.Bt + (size_t)nxt.pn * tstep : cB;
        for (int t = 0; t < nt; t += 2) {
            if constexpr (Epi::KGROUP) { if ((t & 7) == 0) E.kgroup(acc, lds, t >> 3, wr, fr); }
            const bool last = (t == nt - 2);
            const char* a1 = cA + (size_t)(t + 1) * kstep;
            const char* a2 = last ? nA : cA + (size_t)(t + 2) * kstep; const char* b2 = last ? nB : cB + (size_t)(t + 2) * kstep;
            const char* a3 = a2 + kstep; const char* b3 = b2 + kstep;
            if (last && has_next) S.a_ready(nxt);
            if constexpr (SP2) {
            PG8_LDB(B0, 0, 0); PG8_LDB(B1, 0, 1); PG8_SCHED; PG8_LDA(At, 0, 0); PG8_STAGE(PG8_SA(1, 1), a1 + hstep, voffA);
            PG8_WAIT_V(8); PG8_WAIT_L(0); PG8_BAR; PG8_MMA(0, 0, At, B0); PG8_MMA(0, 1, At, B1); PG8_BAR; PG8_SCHED;
            PG8_LDA(At, 0, 1); PG8_STAGE(PG8_SB(0, 0), b2, voffB); PG8_STAGE(PG8_SB(0, 1), b2 + hstep, voffB); PG8_STAGE(PG8_SA(0, 0), a2, voffA);
            PG8_WAIT_V(8); PG8_WAIT_L(0); PG8_BAR; PG8_MMA(1, 0, At, B0); PG8_MMA(1, 1, At, B1); PG8_BAR; PG8_SCHED;
            PG8_LDB(B0, 1, 0); PG8_LDB(B1, 1, 1); PG8_SCHED; PG8_LDA(At, 1, 0); PG8_STAGE(PG8_SA(0, 1), a2 + hstep, voffA);
            PG8_WAIT_V(8); PG8_WAIT_L(0); PG8_BAR; PG8_MMA(0, 0, At, B0); PG8_MMA(0, 1, At, B1); PG8_BAR; PG8_SCHED;
            PG8_LDA(At, 1, 1); PG8_STAGE(PG8_SB(1, 0), b3, voffB); PG8_STAGE(PG8_SB(1, 1), b3 + hstep, voffB); PG8_STAGE(PG8_SA(1, 0), a3, voffA);
            PG8_WAIT_V(8); PG8_WAIT_L(0); PG8_BAR; PG8_MMA(1, 0, At, B0); PG8_MMA(1, 1, At, B1); PG8_BAR; PG8_SCHED;
            } else {
            PG8_LDB(B0, 0, 0); PG8_SCHED; PG8_LDA(At, 0, 0); PG8_STAGE(PG8_SA(1, 1), a1 + hstep, voffA);
            PG8_WAIT_L(8); PG8_BAR; PG8_WAIT_L(0); PG8_MMA(0, 0, At, B0); PG8_BAR; PG8_SCHED;
            PG8_LDB(B1, 0, 1); PG8_STAGE(PG8_SB(0, 0), b2, voffB);
            PG8_BAR; PG8_WAIT_L(0); PG8_MMA(0, 1, At, B1); PG8_BAR;
            PG8_LDA(At, 0, 1); PG8_STAGE(PG8_SA(0, 0), a2, voffA);
            PG8_BAR; PG8_WAIT_L(0); PG8_MMA(1, 0, At, B0); PG8_BAR; PG8_SCHED;
            PG8_STAGE(PG8_SB(0, 1), b2 + hstep, voffB);
            PG8_WAIT_V(6); PG8_BAR; PG8_MMA(1, 1, At, B1); PG8_BAR;
            PG8_LDB(B0, 1, 0); PG8_SCHED; PG8_LDA(At, 1, 0); PG8_STAGE(PG8_SA(0, 1), a2 + hstep, voffA);
            PG8_WAIT_L(8); PG8_BAR; PG8_WAIT_L(0); PG8_MMA(0, 0, At, B0); PG8_BAR; PG8_SCHED;
            PG8_LDB(B1, 1, 1); PG8_STAGE(PG8_SB(1, 0), b3, voffB);
            PG8_BAR; PG8_WAIT_L(0); PG8_MMA(0, 1, At, B1); PG8_BAR;
            PG8_LDA(At, 1, 1); PG8_STAGE(PG8_SA(1, 0), a3, voffA);
            PG8_BAR; PG8_WAIT_L(0); PG8_MMA(1, 0, At, B0); PG8_BAR; PG8_SCHED;
            PG8_STAGE(PG8_SB(1, 1), b3 + hstep, voffB);
            PG8_WAIT_V(6); PG8_BAR; PG8_MMA(1, 1, At, B1); PG8_BAR;
            }
        }
        if constexpr (ALIGN_EPI) { if (wr == 0) PG8_BAR; }
        if constexpr (!Epi::AFTER_DRAIN) { E(acc, cur, wr, wc, fr, fq); S.done(cur); }
        if (!has_next) break;
#pragma unroll
        for (int a = 0; a < 2; ++a)
#pragma unroll
            for (int b = 0; b < 2; ++b)
#pragma unroll
                for (int m = 0; m < 4; ++m)
#pragma unroll
                    for (int n = 0; n < 2; ++n) acc[a][b][m][n] = (f32x4){0.f, 0.f, 0.f, 0.f};
        cur = nxt; cA = nA; cB = nB; ++ui;
        if constexpr (Epi::KGROUP) E.unit_begin(cur, lds, wr, fr);
        if constexpr (ALIGN_EPI) { if (wr == 1) PG8_BAR; }
    }
    PG8_WAIT_V(0);
    if constexpr (!ALIGN_EPI) { if (wr == 0) PG8_BAR; }
    PG8_BAR;
    if constexpr (Epi::AFTER_DRAIN) { E.fused(acc, cur, wr, wc, fr, fq, lds, wid, lane); S.done(cur); }
#undef PG8_SA
#undef PG8_SB
#undef PG8_STAGE
#undef PG8_LDA
#undef PG8_LDB
#undef PG8_MMA
#undef PG8_WAIT_V
#undef PG8_WAIT_L
#undef PG8_BAR
#undef PG8_SCHED
}
}
#define GAS __attribute__((address_space(1)))
#define LAS __attribute__((address_space(3)))
typedef unsigned short bf16;
typedef short bf16x8 __attribute__((ext_vector_type(8)));
typedef short s16x4 __attribute__((ext_vector_type(4)));
typedef float f32x4 __attribute__((ext_vector_type(4)));
typedef float f32x2 __attribute__((ext_vector_type(2)));
typedef float f32x16 __attribute__((ext_vector_type(16)));
typedef unsigned u32x4 __attribute__((ext_vector_type(4)));
typedef unsigned u32x2 __attribute__((ext_vector_type(2)));
typedef GAS unsigned gu32;
#define RLX_AGENT __ATOMIC_RELAXED, __HIP_MEMORY_SCOPE_AGENT
#define LDS_WAIT() asm volatile("s_waitcnt lgkmcnt(0)" ::: "memory")
__device__ __forceinline__ f32x4 ldnt4(const float* p) { return __builtin_nontemporal_load((const f32x4*)p); }
#define PRIO_HI() __builtin_amdgcn_s_setprio(1)
#define PRIO_LO() __builtin_amdgcn_s_setprio(0)
#define SCHED_FENCE() __builtin_amdgcn_sched_barrier(0)
#define VM_WAIT() asm volatile("s_waitcnt vmcnt(0)" ::: "memory")

typedef __bf16 bf16x2_t __attribute__((ext_vector_type(2)));
__device__ __forceinline__ unsigned pk2(float lo, float hi) { const f32x2 v = {lo, hi}; const bf16x2_t b = __builtin_convertvector(v, bf16x2_t); return __builtin_bit_cast(unsigned, b); }
__device__ __forceinline__ unsigned f2bf(float f) { return pk2(f, 0.f) & 0xffffu; }
__device__ __forceinline__ float bf2f(unsigned h) { return __builtin_bit_cast(float, h << 16); }
__device__ __forceinline__ float bflo(unsigned w) { return __builtin_bit_cast(float, w << 16); }
__device__ __forceinline__ float bfhi(unsigned w) { return __builtin_bit_cast(float, w & 0xffff0000u); }
template <int CTRL> __device__ __forceinline__ float dpp_mov(float v) { return __builtin_bit_cast(float, __builtin_amdgcn_update_dpp(0, __builtin_bit_cast(int, v), CTRL, 0xF, 0xF, false)); }
__device__ __forceinline__ float wave_sum(float v) {
    v += dpp_mov<0xB1>(v); v += dpp_mov<0x4E>(v); v += dpp_mov<0x124>(v); v += dpp_mov<0x128>(v);
    const int b = __builtin_bit_cast(int, v);
    const float s0 = __builtin_bit_cast(float, __builtin_amdgcn_readlane(b, 0)), s1 = __builtin_bit_cast(float, __builtin_amdgcn_readlane(b, 16));
    const float s2 = __builtin_bit_cast(float, __builtin_amdgcn_readlane(b, 32)), s3 = __builtin_bit_cast(float, __builtin_amdgcn_readlane(b, 48));
    return (s0 + s1) + (s2 + s3);
}
__device__ __forceinline__ float xhalf(float v) { const unsigned u = __builtin_bit_cast(unsigned, v); const auto r = __builtin_amdgcn_permlane32_swap(u, u, false, false);
    const int hi = (int)(__builtin_amdgcn_mbcnt_hi(~0u, __builtin_amdgcn_mbcnt_lo(~0u, 0u)) >> 5); return __builtin_bit_cast(float, hi ? r[0] : r[1]); }
__device__ __forceinline__ float sigmoidf_(float x) { return __builtin_amdgcn_rcpf(1.f + __expf(-x)); }
__device__ __forceinline__ float siluf_(float x) { return x * __builtin_amdgcn_rcpf(1.f + __expf(-x)); }
__device__ __forceinline__ float max3f(float a, float b, float c) { float r; asm("v_max3_f32 %0, %1, %2, %3" : "=v"(r) : "v"(a), "v"(b), "v"(c)); return r; }
__device__ __forceinline__ float max2f(float a, float b) { float r; asm("v_max_f32_e32 %0, %1, %2" : "=v"(r) : "v"(a), "v"(b)); return r; }
__device__ __forceinline__ int crow(int r, int hi) { return (r & 3) + 8 * (r >> 2) + 4 * hi; }
__device__ __forceinline__ f32x16 mfma32(bf16x8 a, bf16x8 b, f32x16 c) { return __builtin_amdgcn_mfma_f32_32x32x16_bf16(a, b, c, 0, 0, 0); }
typedef short v4i16_t __attribute__((ext_vector_type(4)));
__device__ __forceinline__ s16x4 tr_read(const LAS unsigned char* p) { return __builtin_bit_cast(s16x4, __builtin_amdgcn_ds_read_tr16_b64_v4i16((LAS v4i16_t*)p)); }
__device__ __forceinline__ bf16x8 cat4(s16x4 lo, s16x4 hi) { return (bf16x8){lo[0], lo[1], lo[2], lo[3], hi[0], hi[1], hi[2], hi[3]}; }
__device__ __forceinline__ bf16x8 pack8(float a0, float a1, float a2, float a3, float a4, float a5, float a6, float a7) {
    u32x4 w; w.x = pk2(a0, a1); w.y = pk2(a2, a3); w.z = pk2(a4, a5); w.w = pk2(a6, a7); return __builtin_bit_cast(bf16x8, w);
}

constexpr int DM = 1024, MP = 16384, MS = 128, MT = MP + MS, MR = 16640, TP = 2048, NBP = 8, NBS = 32, TS = 4;
constexpr float EPS = 1e-6f;
constexpr float LOG2E = 1.4426950408889634f;
constexpr float C_MLA = 0.10206207261596575f * LOG2E;
constexpr float C_X = 0.0625f * LOG2E;

constexpr size_t O_Y = 0, O_YS = O_Y + (size_t)MP * DM, O_CKVP = O_YS + (size_t)MS * DM, O_CKVS = O_CKVP + (size_t)MP * 128, O_KRP = O_CKVS + (size_t)MS * 128,
    O_KRS = O_KRP + (size_t)MP * 32, O_CAP = O_KRS + (size_t)MS * 32, O_CAS = O_CAP + (size_t)8 * 30 * 512, O_CCP = O_CAS + (size_t)32 * 30 * 512,
    O_CCS = O_CCP + (size_t)8 * 3 * 3072, O_SSMP = O_CCS + (size_t)32 * 3 * 3072, O_SSMS = O_SSMP + (size_t)8 * 32 * 64 * 128, O_MK = O_SSMS + (size_t)32 * 32 * 64 * 128,
    O_MV = O_MK + (size_t)2 * 2048 * 1024, O_END = O_MV + (size_t)2 * 2048 * 1024;

constexpr size_t al256(size_t x) { return (x + 255) & ~(size_t)255; }
constexpr size_t WS_CTL = 0, CTL_BYTES = 1u << 20;
constexpr size_t WS_WEIN = CTL_BYTES;
constexpr size_t WS_WMKV = WS_WEIN + (size_t)2560 * 1024 * 2;
constexpr size_t WS_WQ = WS_WMKV + (size_t)2 * 2048 * 1024 * 2;
constexpr size_t WS_WUVT = WS_WQ + (size_t)1280 * 256 * 2;
constexpr size_t WS_WEOUT = WS_WUVT + (size_t)8 * 64 * 128 * 2;
constexpr size_t WS_WQG = WS_WEOUT + (size_t)1024 * 1024 * 2;
constexpr size_t WS_WXO = WS_WQG + (size_t)2 * 2048 * 1024 * 2;
constexpr size_t WS_WOIN = WS_WXO + (size_t)2 * 1024 * 1024 * 2;
constexpr size_t WS_WDT = WS_WOIN + (size_t)5120 * 1024 * 2;
constexpr size_t WS_WOOUT = WS_WDT + (size_t)32 * 1024 * 2;
constexpr size_t WS_ROPE = WS_WOOUT + (size_t)1024 * 2048 * 2;
constexpr size_t WS_H = al256(WS_ROPE + (size_t)2052 * 32 * 4);
constexpr size_t WS_MN = WS_H + (size_t)MR * 1024 * 2;
constexpr size_t WS_GLU = WS_MN + (size_t)2 * 2048 * 1024 * 2;
constexpr size_t WS_GATE = WS_GLU + (size_t)MR * 512 * 2;
constexpr size_t WS_CQ = WS_GATE + (size_t)MR * 1024 * 2;
constexpr size_t WS_CQN = WS_CQ + (size_t)MR * 256 * 2;
constexpr size_t WS_KVRAW = WS_CQN + (size_t)MR * 256 * 2;
constexpr size_t WS_KP = WS_KVRAW + (size_t)MR * 256 * 2;
constexpr size_t WS_QP = WS_KP + (size_t)MR * 160 * 2;
constexpr size_t WS_YCAT = WS_QP + (size_t)MR * 1280 * 2;
constexpr size_t WS_YB = WS_YCAT + (size_t)MR * 1024 * 2;
constexpr size_t WS_XQ = WS_YB + (size_t)MR * 1024 * 2;
constexpr size_t WS_XG = WS_XQ + (size_t)MR * 1024 * 2;
constexpr size_t WS_XO = WS_XG + (size_t)MR * 1024 * 2;
constexpr size_t WS_MKV = WS_XO + (size_t)MR * 1024 * 2;
constexpr size_t WS_ZS = WS_MKV + (size_t)4 * 2048 * 1024 * 2;
constexpr size_t WS_XBC = WS_ZS + (size_t)MR * 2048 * 2;
constexpr size_t WS_XBCC = WS_XBC + (size_t)MR * 3072 * 2;
constexpr size_t WS_DT = WS_XBCC + (size_t)MR * 3072 * 2;
constexpr size_t WS_YZ = WS_DT + (size_t)MR * 32 * 4;
constexpr size_t WS_YN = WS_YZ + (size_t)MR * 2048 * 2;
constexpr size_t PART_STRIDE = 4096 + 64;
constexpr size_t WS_PART = WS_YN + (size_t)MR * 2048 * 2;
constexpr size_t WS_XR = WS_PART + (size_t)32 * 64 * PART_STRIDE * 4;
constexpr size_t WS_GS = WS_XR + (size_t)MR * 1024 * 2;
constexpr size_t WS_END = WS_GS + (size_t)MR * 4 * 4;

constexpr int LDS_BYTES = 147456, RING_BYTES = 131072, MISC_OFF = LDS_BYTES - 256;
constexpr int CW_BAR = 4096;
#define XB_TMO      128
#define XB_XCNT(j)  (256  + 64 * (j))
#define XB_XSUB(j)  (1280 + 64 * (j))
#define XB_XGEN(j)  (2304 + 64 * (j))
#define XB_TOP      3328
#define XB_TOPGEN   3392
#define XCD_BAR_WORDS 3456
#define XB_SPIN_CAP (1u << 18)

__device__ __forceinline__ unsigned xb_ld(unsigned* p)              { return __hip_atomic_load(p, __ATOMIC_RELAXED, __HIP_MEMORY_SCOPE_AGENT); }
__device__ __forceinline__ unsigned xb_add(unsigned* p, unsigned v) { return __hip_atomic_fetch_add(p, v, __ATOMIC_RELAXED, __HIP_MEMORY_SCOPE_AGENT); }
__device__ __forceinline__ unsigned xb_xcc_id() { return (unsigned)__builtin_amdgcn_s_getreg((3 << 11) | 20) & 0xFu; }
#define XB_SPIN(cond, bar) do { unsigned _sp = 0; while (cond) { __builtin_amdgcn_s_sleep(1); \
    if ((++_sp & 255u) == 0u) { if (xb_ld(&(bar)[XB_TMO])) break; if (_sp > XB_SPIN_CAP) { atomicAdd(&(bar)[XB_TMO], 1u); break; } } } } while (0)

struct XcdBarrier {
    unsigned* bar; unsigned x;
    volatile LAS unsigned* st;
};

__device__ __forceinline__ XcdBarrier xcd_barrier_post(unsigned* bar, volatile LAS unsigned* st, int tid) {
    XcdBarrier b; b.bar = bar; b.x = xb_xcc_id(); b.st = st;
    if (tid == 0) (void)xb_add(&bar[XB_XCNT(b.x)], 1u);
    return b;
}
__device__ __forceinline__ void xcd_barrier_complete(unsigned* bar, unsigned x, unsigned& nloc, unsigned& nx) {
    const unsigned G = gridDim.x * gridDim.y * gridDim.z;
    unsigned sum, cnt, mine, sp = 0u;
    for (;;) {
        sum = 0u; cnt = 0u; mine = 0u;
#pragma unroll
        for (unsigned j = 0; j < 16; ++j) { const unsigned c = xb_ld(&bar[XB_XCNT(j)]); sum += c; cnt += (c > 0u) ? 1u : 0u; mine = (j == x) ? c : mine; }
        if (sum == G) break;
        __builtin_amdgcn_s_sleep(1);
        if ((++sp & 255u) == 0u) { if (xb_ld(&bar[XB_TMO])) break; if (sp > XB_SPIN_CAP) { atomicAdd(&bar[XB_TMO], 1u); break; } }
    }
    nloc = mine > 0u ? mine : 1u; nx = cnt > 0u ? cnt : 1u;
}

__device__ __forceinline__ void xcd_barrier(const XcdBarrier& b, int tid) {
    asm volatile("s_waitcnt vmcnt(0)" ::: "memory");
    __syncthreads();
    if (tid == 0) {
        unsigned* bar = b.bar;
        __builtin_amdgcn_s_waitcnt(0);
        unsigned nloc = b.st[0], nx = b.st[1];
        if (nloc == 0u) { xcd_barrier_complete(bar, b.x, nloc, nx); b.st[0] = nloc; b.st[1] = nx; }
        const unsigned old = xb_add(&bar[XB_XSUB(b.x)], 1u);
        const unsigned gen = old / nloc;
        if (old + 1u == (gen + 1u) * nloc) {
            __builtin_amdgcn_fence(__ATOMIC_RELEASE, "agent");
            asm volatile("s_waitcnt vmcnt(0)" ::: "memory");
            const unsigned og = xb_add(&bar[XB_TOP], 1u);
            const unsigned tg = og / nx;
            if (og + 1u == (tg + 1u) * nx) xb_add(&bar[XB_TOPGEN], 1u);
            else XB_SPIN(xb_ld(&bar[XB_TOPGEN]) == tg, bar);
            __builtin_amdgcn_fence(__ATOMIC_ACQUIRE, "agent");
            xb_add(&bar[XB_XGEN(b.x)], 1u);
            asm volatile("s_waitcnt vmcnt(0)" ::: "memory");
        } else {
            XB_SPIN(xb_ld(&bar[XB_XGEN(b.x)]) == gen, bar);
            __builtin_amdgcn_fence(__ATOMIC_ACQUIRE, "agent");
            asm volatile("s_waitcnt vmcnt(0)" ::: "memory");
        }
    }
    __syncthreads();
}
struct Params { const float* in[39]; float* out; unsigned char* ws; int ph_lo, ph_hi; };
struct Ctx { LAS unsigned char* lds; int tid, lane, wave, G, cu, gw, NGW; };

#define IN_XP 0
#define IN_XS 1
#define IN_MEM 2
#define IN_CCKV 3
#define IN_CKR 4
#define IN_PT 5
#define IN_SCA 6
#define IN_SCC 7
#define IN_SSM 8
#define IN_CMK 9
#define IN_CMV 10
#define IN_NPM 11
#define IN_NQM 12
#define IN_NPX 13
#define IN_NQX 14
#define IN_NMEM 15
#define IN_XWQG 16
#define IN_XWK 17
#define IN_XWV 18
#define IN_XWO 19
#define IN_EWIN 20
#define IN_ECW 21
#define IN_ECB 22
#define IN_ELNW 23
#define IN_ELNB 24
#define IN_EQN 25
#define IN_EKVN 26
#define IN_EWUQ 27
#define IN_EWUK 28
#define IN_EWUV 29
#define IN_EWOUT 30
#define IN_OWIN 31
#define IN_OCW 32
#define IN_OCB 33
#define IN_ODTB 34
#define IN_OALOG 35
#define IN_OD 36
#define IN_ONORM 37
#define IN_OWOUT 38

template <int W> __device__ __forceinline__ void store_bf(bf16* dst, const float (&v)[W]) {
    if constexpr (W == 8) { u32x4 w; w.x = pk2(v[0], v[1]); w.y = pk2(v[2], v[3]); w.z = pk2(v[4], v[5]); w.w = pk2(v[6], v[7]); *(u32x4*)dst = w; }
    else if constexpr (W == 4) { u32x2 w; w.x = pk2(v[0], v[1]); w.y = pk2(v[2], v[3]); *(u32x2*)dst = w; }
    else { static_assert(W == 2, "W"); *(unsigned*)dst = pk2(v[0], v[1]); }
}

template <class F> struct Epi8 {
    static constexpr bool PERM = true, AFTER_DRAIN = false, KGROUP = false;
    F f;
    __device__ __forceinline__ void operator()(const pg8::f32x4 (&acc)[2][2][4][2], const pg8::Unit& u, int wr, int wc, int fr, int fq) const {
        const int row0 = u.pm * 256 + wr * 64 + fr, col0 = u.pn * 256 + wc * 32 + 8 * fq;
#pragma unroll
        for (int ai = 0; ai < 2; ++ai)
#pragma unroll
            for (int m = 0; m < 4; ++m)
#pragma unroll
                for (int bj = 0; bj < 2; ++bj) {
                    const float v[8] = {acc[ai][bj][m][0][0], acc[ai][bj][m][0][1], acc[ai][bj][m][0][2], acc[ai][bj][m][0][3],
                                        acc[ai][bj][m][1][0], acc[ai][bj][m][1][1], acc[ai][bj][m][1][2], acc[ai][bj][m][1][3]};
                    f.template operator()<8>(row0 + ai * 128 + m * 16, col0 + bj * 128, v);
                }
    }
};

struct EpiGN {
    static constexpr bool PERM = true, AFTER_DRAIN = false, KGROUP = true;
    bf16* O; const float* GS;
    __device__ __forceinline__ void unit_begin(const pg8::Unit& u, PG8_LAS unsigned char* lds, int wr, int fr) const {
        int fr_ = fr; asm volatile("" : "+v"(fr_));
        PG8_LAS f32x4* T = (PG8_LAS f32x4*)(lds + RING_BYTES) + (wr * 128 + fr_) * 2;
        const float* gp = GS + (size_t)(u.pm * 256 + wr * 64 + fr_) * 4;
#pragma unroll 1
        for (int i = 0; i < 8; ++i) {
            const f32x4 s = *(const f32x4*)(gp + (size_t)((i >> 2) * 128 + (i & 3) * 16) * 4);
            const float q0 = s.x * (1.f / 512.f) + EPS, q1 = s.y * (1.f / 512.f) + EPS, q2 = s.z * (1.f / 512.f) + EPS, q3 = s.w * (1.f / 512.f) + EPS;
            const float r0 = rsqrtf(q0), r1 = rsqrtf(q1), r2 = rsqrtf(q2), r3 = rsqrtf(q3);
            T[i * 32] = (f32x4){1.f, r0 * (q1 * r1), r1 * (q2 * r2), r2 * (q3 * r3)}; T[i * 32 + 1] = (f32x4){r3, 0.f, 0.f, 0.f};
        }
    }
    __device__ __forceinline__ void kgroup(pg8::f32x4 (&acc)[2][2][4][2], PG8_LAS unsigned char* lds, int g, int wr, int fr) const {
        int fr_ = fr; asm volatile("" : "+v"(fr_));
        const unsigned tb_ = (unsigned)(RING_BYTES + wr * 4096 + fr_ * 32 + g * 4);
        const PG8_LAS float* T = (const PG8_LAS float*)(lds + tb_);
#pragma unroll
        for (int ai = 0; ai < 2; ++ai)
#pragma unroll
            for (int m = 0; m < 4; ++m) { const float r = T[(ai * 64 + m * 16) * 8];
#pragma unroll
                for (int bj = 0; bj < 2; ++bj)
#pragma unroll
                    for (int n = 0; n < 2; ++n) acc[ai][bj][m][n] *= r; }
    }
    PG8_LAS unsigned char* ldsb; int multi;
    __device__ __forceinline__ void operator()(const pg8::f32x4 (&acc)[2][2][4][2], const pg8::Unit& u, int wr, int wc, int fr, int fq) const {
        const int row0 = u.pm * 256 + wr * 64 + fr, col0 = u.pn * 256 + wc * 32 + 8 * fq;
        int fr_ = fr; asm volatile("" : "+v"(fr_));
        const unsigned tb_ = (unsigned)(RING_BYTES + wr * 4096 + fr_ * 32 + 16);
        const PG8_LAS float* T = (const PG8_LAS float*)(ldsb + tb_);
#pragma unroll
        for (int ai = 0; ai < 2; ++ai)
#pragma unroll
            for (int m = 0; m < 4; ++m) { const int row = row0 + ai * 128 + m * 16;
                const float r3 = multi ? rsqrtf(GS[(size_t)row * 4 + 3] * (1.f / 512.f) + EPS) : T[(ai * 64 + m * 16) * 8];
#pragma unroll
                for (int bj = 0; bj < 2; ++bj) {
                    const float v[8] = {acc[ai][bj][m][0][0] * r3, acc[ai][bj][m][0][1] * r3, acc[ai][bj][m][0][2] * r3, acc[ai][bj][m][0][3] * r3,
                                        acc[ai][bj][m][1][0] * r3, acc[ai][bj][m][1][1] * r3, acc[ai][bj][m][1][2] * r3, acc[ai][bj][m][1][3] * r3};
                    store_bf<8>(O + (size_t)row * 1024 + col0 + bj * 128, v); } }
    }
};

template <bool GN = false, class F>
__device__ __forceinline__ void skinny_unit(const Ctx& c, const bf16* A, int lda, const bf16* Bt, int ldb, int K, int rowT0, int colT0, int rowT1, int colT1, const F& f) {
    const int lane = c.lane, r32 = lane & 31, hi = lane >> 5, w = c.wave, tile = w & 1, ks = w >> 1;
    const int row0 = tile ? rowT1 : rowT0, col0 = tile ? colT1 : colT0, Ks = K >> 2;
    const bf16* ap = A + (size_t)(row0 + r32) * lda + ks * Ks + 8 * hi;
    const bf16* bp = Bt + (size_t)(col0 + r32) * ldb + ks * Ks + 8 * hi;
    f32x16 acc = {}; float gss = 0.f;
#pragma unroll 2
    for (int k = 0; k < Ks; k += 64) {
        const bf16x8 a0 = *(const bf16x8*)(ap + k), a1 = *(const bf16x8*)(ap + k + 16), a2 = *(const bf16x8*)(ap + k + 32), a3 = *(const bf16x8*)(ap + k + 48);
        const bf16x8 b0 = *(const bf16x8*)(bp + k), b1 = *(const bf16x8*)(bp + k + 16), b2 = *(const bf16x8*)(bp + k + 32), b3 = *(const bf16x8*)(bp + k + 48);
        acc = mfma32(b0, a0, acc); acc = mfma32(b1, a1, acc); acc = mfma32(b2, a2, acc); acc = mfma32(b3, a3, acc);
        if constexpr (GN) {
#pragma unroll
            for (int j = 0; j < 8; ++j) { const float x0 = bf2f((unsigned short)a0[j]), x1 = bf2f((unsigned short)a1[j]), x2 = bf2f((unsigned short)a2[j]), x3 = bf2f((unsigned short)a3[j]); gss += (x0 * x0 + x1 * x1) + (x2 * x2 + x3 * x3); } }
    }
    if constexpr (GN) { gss += xhalf(gss); acc *= rsqrtf(gss * (1.f / 512.f) + EPS); }
    LAS float* P = (LAS float*)c.lds;
#pragma unroll
    for (int r = 0; r < 16; ++r) P[(w * 16 + r) * 64 + lane] = acc[r];
    __syncthreads();
    {
        const int g = w >> 1; float v[4];
#pragma unroll
        for (int i = 0; i < 4; ++i) { const int r = 4 * g + i; v[i] = (P[((tile + 0) * 16 + r) * 64 + lane] + P[((tile + 2) * 16 + r) * 64 + lane]) + (P[((tile + 4) * 16 + r) * 64 + lane] + P[((tile + 6) * 16 + r) * 64 + lane]); }
        f.template operator()<4>(row0 + r32, col0 + 8 * g + 4 * hi, v);
    }
    __syncthreads();
}
template <bool GN = false, class F>
__device__ __forceinline__ void skinny_sample(const Ctx& c, const bf16* A, int lda, const bf16* Bt, int ldb, int K, int ncols, const F& f, int cu_rot) {
    const int vc = (c.cu + c.G - cu_rot % c.G) % c.G;
    for (int u = vc; u < (ncols / 64) * 4; u += c.G) { const bf16* Au = A; asm volatile("" : "+s"(Au));
        const int rb = u & 3, cp = u >> 2; skinny_unit<GN>(c, Au, lda, Bt, ldb, K, MP + 32 * rb, 64 * cp, MP + 32 * rb, 64 * cp + 32, f); }
}

struct FGemm1 {
    bf16 *GLU, *GATE, *CQ, *KVRAW;
    template <int W> __device__ __forceinline__ void operator()(int row, int col, const float (&v)[W]) const {
        if (col < 1024) { float o[W / 2];
#pragma unroll
            for (int i = 0; i < W / 2; ++i) o[i] = v[2 * i] * sigmoidf_(v[2 * i + 1]);
            store_bf<W / 2>(GLU + (size_t)row * 512 + (col >> 1), o); }
        else if (col < 1536) { float o[W];
#pragma unroll
            for (int i = 0; i < W; ++i) o[i] = siluf_(v[i]);
            store_bf<W>(GATE + (size_t)row * 1024 + (col - 1024), o); }
        else if (col < 1792) store_bf<W>(CQ + (size_t)row * 256 + (col - 1536), v);
        else if (col < 2304) { float o[W];
#pragma unroll
            for (int i = 0; i < W; ++i) o[i] = siluf_(v[i]);
            store_bf<W>(GATE + (size_t)row * 1024 + 512 + (col - 1792), o); }
        else store_bf<W>(KVRAW + (size_t)row * 256 + (col - 2304), v);
    }
};
struct FMemKV {
    float *OK, *OV; bf16 *BK, *BV;
    template <int W> __device__ __forceinline__ void operator()(int row, int col, const float (&v)[W]) const {
        float* o = (col < 1024) ? OK + (size_t)row * 1024 + col : OV + (size_t)row * 1024 + (col - 1024);
        bf16* b = (col < 1024) ? BK + (size_t)row * 1024 + col : BV + (size_t)row * 1024 + (col - 1024);
#pragma unroll
        for (int i = 0; i < W; i += 4) *(f32x4*)(o + i) = (f32x4){v[i], v[i + 1], v[i + 2], v[i + 3]};
        store_bf<W>(b, v);
    }
};
__device__ __forceinline__ int pos_index(int row) { return row < MP ? (row & (TP - 1)) : TP + ((row - MP) & 3); }
struct FQ {
    bf16* QP; const float* ROPE;
    template <int W> __device__ __forceinline__ void operator()(int row, int col, const float (&v)[W]) const {
        float o[W];
        if (col < 1024) {
#pragma unroll
            for (int i = 0; i < W; ++i) o[i] = v[i] * C_MLA;
        } else { const float* rp = ROPE + ((size_t)pos_index(row) * 16 + (((col - 1024) & 31) >> 1)) * 2;
#pragma unroll
            for (int i = 0; i < W / 2; ++i) { const float cs = rp[2 * i], sn = rp[2 * i + 1], x1 = v[2 * i] * C_MLA, x2 = v[2 * i + 1] * C_MLA; o[2 * i] = x1 * cs - x2 * sn; o[2 * i + 1] = x1 * sn + x2 * cs; }
        }
        store_bf<W>(QP + (size_t)row * 1280 + col, o);
    }
};
struct FPlain { bf16* O; int ldo;
    template <int W> __device__ __forceinline__ void operator()(int row, int col, const float (&v)[W]) const { store_bf<W>(O + (size_t)row * ldo + col, v); }
};
struct FQG {
    bf16 *XQ, *XG;
    template <int W> __device__ __forceinline__ void operator()(int row, int col, const float (&v)[W]) const {
        float o[W];
        if (col < 1024) {
#pragma unroll
            for (int i = 0; i < W; ++i) o[i] = v[i] * C_X;
            store_bf<W>(XQ + (size_t)row * 1024 + col, o);
        } else {
#pragma unroll
            for (int i = 0; i < W; ++i) o[i] = siluf_(v[i]);
            store_bf<W>(XG + (size_t)row * 1024 + (col - 1024), o);
        }
    }
};
struct FOIn {
    bf16 *ZS, *XBC;
    template <int W> __device__ __forceinline__ void operator()(int row, int col, const float (&v)[W]) const {
        if (col < 2048) { float o[W];
#pragma unroll
            for (int i = 0; i < W; ++i) o[i] = siluf_(v[i]);
            store_bf<W>(ZS + (size_t)row * 2048 + col, o); }
        else store_bf<W>(XBC + (size_t)row * 3072 + (col - 2048), v);
    }
};
struct FDt {
    float* DT; const float* bias;
    template <int W> __device__ __forceinline__ void operator()(int row, int col, const float (&v)[W]) const {
#pragma unroll
        for (int i = 0; i < W; ++i) { const float x = v[i] + bias[col + i]; DT[(size_t)row * 32 + col + i] = x > 20.f ? x : log1pf(__expf(x)); }
    }
};
__device__ __forceinline__ int ein_src_col(int n) {
    if (n < 1024) return (n & 1) ? 512 + (n >> 1) : (n >> 1);
    if (n < 1792) return n;
    if (n < 2304) return 1952 + (n - 1792);
    if (n < 2464) return 1792 + (n - 2304);
    return -1;
}
__device__ __forceinline__ void transpose_item(const float* W, int K, int N, bf16* WT, int drows, int kind, int coff, int item, LAS float* scr, int lane, const float* kscale = nullptr) {
    const int nblk = drows / 32, kb = item / nblk, nb = item % nblk, k0 = 64 * kb, n0 = 32 * nb;
    const int nd = n0 + (lane & 31);
    const int sn = kind == 1 ? ein_src_col(nd) : nd + coff;
#pragma unroll 8
    for (int i = 0; i < 32; ++i) { const int kk = 2 * i + (lane >> 5); float v_ = sn >= 0 ? W[(size_t)(k0 + kk) * N + sn] : 0.f; if (kscale) v_ *= kscale[k0 + kk]; scr[kk * 33 + (lane & 31)] = v_; }
    LDS_WAIT(); asm volatile("" ::: "memory");
    const int c = lane & 7;
#pragma unroll
    for (int j = 0; j < 4; ++j) { const int n = (lane >> 3) + 8 * j; const LAS float* s = scr + (8 * c) * 33 + n;
        u32x4 o; o.x = pk2(s[0 * 33], s[1 * 33]); o.y = pk2(s[2 * 33], s[3 * 33]); o.z = pk2(s[4 * 33], s[5 * 33]); o.w = pk2(s[6 * 33], s[7 * 33]);
        *(u32x4*)(WT + (size_t)(n0 + n) * K + k0 + 8 * c) = o; }
    LDS_WAIT(); asm volatile("" ::: "memory");
}
__device__ __forceinline__ void rms_row_to_bf16(const float* xrow, const float* w, bf16* orow, int lane) {
    const f32x4* xr = (const f32x4*)xrow + lane; const f32x4* wr = (const f32x4*)w + lane;
    f32x4 v[4]; float s = 0.f;
#pragma unroll
    for (int j = 0; j < 4; ++j) { v[j] = xr[64 * j]; s += (v[j].x * v[j].x + v[j].y * v[j].y) + (v[j].z * v[j].z + v[j].w * v[j].w); }
    const float r = rsqrtf(wave_sum(s) * (1.f / 1024.f) + EPS);
    u32x2* o8 = (u32x2*)orow + lane;
#pragma unroll
    for (int j = 0; j < 4; ++j) { const f32x4 ww = wr[64 * j]; u32x2 o; o.x = pk2(v[j].x * r * ww.x, v[j].y * r * ww.y); o.y = pk2(v[j].z * r * ww.z, v[j].w * r * ww.w); o8[64 * j] = o; }
}
template <bool IN32, bool OUT32>
__device__ __forceinline__ void resid_row(const void* xi, const bf16* y, const float* wpost, void* xo, const float* wpre, bf16* h, int lane) {
    const u32x2* yr = (const u32x2*)y + lane; const f32x4* wq = (const f32x4*)wpost + lane;
    f32x4 yv[4]; float s = 0.f;
#pragma unroll
    for (int j = 0; j < 4; ++j) { const u32x2 t = yr[64 * j]; yv[j] = (f32x4){bflo(t.x), bfhi(t.x), bflo(t.y), bfhi(t.y)}; s += (yv[j].x * yv[j].x + yv[j].y * yv[j].y) + (yv[j].z * yv[j].z + yv[j].w * yv[j].w); }
    f32x4 xv[4];
#pragma unroll
    for (int j = 0; j < 4; ++j) { if constexpr (IN32) xv[j] = ((const f32x4*)xi + lane)[64 * j]; else { const u32x2 t = ((const u32x2*)xi + lane)[64 * j]; xv[j] = (f32x4){bflo(t.x), bfhi(t.x), bflo(t.y), bfhi(t.y)}; } }
    const float r = rsqrtf(wave_sum(s) * (1.f / 1024.f) + EPS);
    float s2 = 0.f;
#pragma unroll
    for (int j = 0; j < 4; ++j) { const f32x4 ww = wq[64 * j]; xv[j] = xv[j] + yv[j] * r * ww; s2 += (xv[j].x * xv[j].x + xv[j].y * xv[j].y) + (xv[j].z * xv[j].z + xv[j].w * xv[j].w); }
#pragma unroll
    for (int j = 0; j < 4; ++j) { if constexpr (OUT32) ((f32x4*)xo + lane)[64 * j] = xv[j]; else { u32x2 o; o.x = pk2(xv[j].x, xv[j].y); o.y = pk2(xv[j].z, xv[j].w); ((u32x2*)xo + lane)[64 * j] = o; } }
    if (wpre) {
        const float r2 = rsqrtf(wave_sum(s2) * (1.f / 1024.f) + EPS);
        const f32x4* wp = (const f32x4*)wpre + lane; u32x2* o8 = (u32x2*)h + lane;
#pragma unroll
        for (int j = 0; j < 4; ++j) { const f32x4 ww = wp[64 * j]; u32x2 o; o.x = pk2(xv[j].x * r2 * ww.x, xv[j].y * r2 * ww.y); o.y = pk2(xv[j].z * r2 * ww.z, xv[j].w * r2 * ww.w); o8[64 * j] = o; }
    }
}
template <int MODE>
__device__ __forceinline__ void phase_resid(const Params& p, const Ctx& c, const float* wpost, const float* wpre) {
    unsigned char* ws = p.ws; const bf16* YB = (const bf16*)(ws + WS_YB); bf16* H = (bf16*)(ws + WS_H); bf16* XR = (bf16*)(ws + WS_XR);
    for (int r = c.gw; r < MT; r += c.NGW) {
        if constexpr (MODE == 0) resid_row<true, false>(r < MP ? p.in[IN_XP] + (size_t)r * DM : p.in[IN_XS] + (size_t)(r - MP) * DM, YB + (size_t)r * DM, wpost, XR + (size_t)r * DM, wpre, H + (size_t)r * DM, c.lane);
        else if constexpr (MODE == 1) resid_row<false, false>(XR + (size_t)r * DM, YB + (size_t)r * DM, wpost, XR + (size_t)r * DM, wpre, H + (size_t)r * DM, c.lane);
        else resid_row<false, true>(XR + (size_t)r * DM, YB + (size_t)r * DM, wpost, p.out + (size_t)r * DM, wpre, H + (size_t)r * DM, c.lane);
    }
}

__device__ __forceinline__ void phase_prep(const Params& p, const Ctx& c) {
    unsigned char* ws = p.ws;
    LAS float* scr = (LAS float*)(c.lds + c.wave * 16384);
    constexpr int J0 = 16 * 80, J1 = 16 * 32, J5 = 16 * 32, J6 = 16 * 64, J8 = 16 * 32, J10 = 16 * 160, J11 = 16 * 1, J12 = 32 * 32;
    constexpr int NIT = J0 + 4 * J1 + J5 + 2 * J6 + 2 * J8 + J10 + J11 + J12;
    for (int it = c.gw; it < NIT; it += c.NGW) {
        int r = it;
        if (r < J0) { transpose_item(p.in[IN_EWIN], 1024, 2464, (bf16*)(ws + WS_WEIN), 2560, 1, 0, r, scr, c.lane); continue; } r -= J0;
        if (r < 4 * J1) { const int q = r / J1, i = q >> 1, kv = q & 1;
            transpose_item(p.in[kv ? IN_XWV : IN_XWK] + (size_t)i * 1024 * 1024, 1024, 1024, (bf16*)(ws + WS_WMKV) + (size_t)(i * 2048 + kv * 1024) * 1024, 1024, 0, 0, r % J1, scr, c.lane); continue; } r -= 4 * J1;
        if (r < J5) { transpose_item(p.in[IN_EWOUT], 1024, 1024, (bf16*)(ws + WS_WEOUT), 1024, 0, 0, r, scr, c.lane); continue; } r -= J5;
        if (r < 2 * J6) { const int i = r / J6; transpose_item(p.in[IN_XWQG] + (size_t)i * 1024 * 2048, 1024, 2048, (bf16*)(ws + WS_WQG) + (size_t)i * 2048 * 1024, 2048, 0, 0, r % J6, scr, c.lane); continue; } r -= 2 * J6;
        if (r < 2 * J8) { const int i = r / J8; transpose_item(p.in[IN_XWO] + (size_t)i * 1024 * 1024, 1024, 1024, (bf16*)(ws + WS_WXO) + (size_t)i * 1024 * 1024, 1024, 0, 0, r % J8, scr, c.lane); continue; } r -= 2 * J8;
        if (r < J10) { transpose_item(p.in[IN_OWIN], 1024, 5152, (bf16*)(ws + WS_WOIN), 5120, 0, 0, r, scr, c.lane); continue; } r -= J10;
        if (r < J11) { transpose_item(p.in[IN_OWIN], 1024, 5152, (bf16*)(ws + WS_WDT), 32, 0, 5120, r, scr, c.lane); continue; } r -= J11;
        transpose_item(p.in[IN_OWOUT], 2048, 1024, (bf16*)(ws + WS_WOOUT), 1024, 0, 0, r, scr, c.lane, p.in[IN_ONORM]);
    }
    const int gt = c.gw * 64 + c.lane, NGT = c.NGW * 64;
    { const float* wuq = p.in[IN_EWUQ]; const float* wuk = p.in[IN_EWUK]; bf16* WQ = (bf16*)(ws + WS_WQ);
      for (int idx = gt; idx < 1280 * 256; idx += NGT) { const int r = idx & 255, n = idx >> 8; float v;
          if (n < 1024) { const int h = n >> 7, cc = n & 127; const f32x4* a = (const f32x4*)(wuq + (size_t)(r * 8 + h) * 96); const f32x4* b = (const f32x4*)(wuk + (size_t)(cc * 8 + h) * 64); float s = 0.f;
#pragma unroll
              for (int i = 0; i < 16; ++i) { const f32x4 x = a[i], y = b[i]; s += (x.x * y.x + x.y * y.y) + (x.z * y.z + x.w * y.w); }
              v = s; }
          else { const int h = (n - 1024) >> 5, e = (n - 1024) & 31; v = wuq[(size_t)(r * 8 + h) * 96 + 64 + (e >> 1) + 16 * (e & 1)]; }
          WQ[(size_t)n * 256 + r] = (bf16)f2bf(v); } }
    { const float* wuv = p.in[IN_EWUV]; bf16* WT = (bf16*)(ws + WS_WUVT);
      for (int idx = gt; idx < 8 * 64 * 128; idx += NGT) { const int cc = idx & 127, v = (idx >> 7) & 63, h = idx >> 13; WT[idx] = (bf16)f2bf(wuv[(size_t)(cc * 8 + h) * 64 + v]); } }
    { float* GSz = (float*)(ws + WS_GS); for (int idx = gt; idx < MR * 4; idx += NGT) GSz[idx] = 0.f; }
    { float* R = (float*)(ws + WS_ROPE);
      for (int idx = gt; idx < 2052 * 16; idx += NGT) { const int pi = idx >> 4, j = idx & 15; const float pos = (float)(pi < TP ? pi : 16384 + (pi - TP));
          const float inv = powf(10000.f, -(float)j / 16.f); float sn, cs; sincosf(pos * inv, &sn, &cs); R[2 * idx] = cs; R[2 * idx + 1] = sn; } }
    bf16* H = (bf16*)(ws + WS_H); bf16* MN = (bf16*)(ws + WS_MN);
    for (int r = c.gw; r < MT + 4096; r += c.NGW) {
        if (r < MT) rms_row_to_bf16(r < MP ? p.in[IN_XP] + (size_t)r * DM : p.in[IN_XS] + (size_t)(r - MP) * DM, p.in[IN_NPM], H + (size_t)r * DM, c.lane);
        else { const int q = r - MT, i = q >> 11, m = q & 2047; rms_row_to_bf16(p.in[IN_MEM] + (size_t)m * DM, p.in[IN_NMEM] + i * DM, MN + (size_t)(i * 2048 + m) * DM, c.lane); }
    }
}
__device__ __forceinline__ void conv_unit(const Params& p, const Ctx& c, int u) {
    unsigned char* ws = p.ws;
    const bf16* GLU = (const bf16*)(ws + WS_GLU); const bf16* GATE = (const bf16*)(ws + WS_GATE); bf16* YCAT = (bf16*)(ws + WS_YCAT);
    LAS unsigned char* G = c.lds;
    LAS float* Y = (LAS float*)(c.lds + 63488);
    const bool samp = u >= 512; const int b = samp ? u - 512 : (u >> 6), tb = samp ? 0 : (u & 63), t0 = tb * 32;
    const int tid = c.tid;
    for (int ch = tid; ch < 62 * 64; ch += 512) {
        const int r = ch >> 6, c16 = ch & 63; u32x4 v = {0u, 0u, 0u, 0u};
        if (!samp) { const int t = t0 - 30 + r; if (t >= 0) v = *(const u32x4*)(GLU + ((size_t)b * TP + t) * 512 + c16 * 8); }
        else if (r < 30) { const f32x4* s = (const f32x4*)(p.in[IN_SCA] + ((size_t)b * 30 + r) * 512 + c16 * 8); const f32x4 a = s[0], d = s[1];
            v.x = pk2(a.x, a.y); v.y = pk2(a.z, a.w); v.z = pk2(d.x, d.y); v.w = pk2(d.z, d.w); }
        else if (r < 34) v = *(const u32x4*)(GLU + ((size_t)MP + 4 * b + (r - 30)) * 512 + c16 * 8);
        *(LAS u32x4*)(G + r * 1024 + c16 * 16) = v;
    }
    __syncthreads();
    {
        const int ch = tid; const float* cw = p.in[IN_ECW]; float w[31];
#pragma unroll
        for (int k = 0; k < 31; ++k) w[k] = cw[k * 512 + ch];
        const float bias = p.in[IN_ECB][ch];
        float g[62];
#pragma unroll
        for (int r = 0; r < 62; ++r) g[r] = bf2f(*(const LAS unsigned short*)(G + r * 1024 + ch * 2));
        f32x2 ge[31], go[30];
#pragma unroll
        for (int j = 0; j < 31; ++j) ge[j] = (f32x2){g[2 * j], g[2 * j + 1]};
#pragma unroll
        for (int j = 0; j < 30; ++j) go[j] = (f32x2){g[2 * j + 1], g[2 * j + 2]};
#pragma unroll
        for (int t = 0; t < 32; t += 2) { f32x2 a = {bias, bias};
#pragma unroll
            for (int k = 0; k < 31; ++k) { const f32x2 wv = {w[k], w[k]}; const f32x2 gp = ((t + k) & 1) ? go[(t + k - 1) >> 1] : ge[(t + k) >> 1]; a = __builtin_elementwise_fma(wv, gp, a); }
            Y[t * 512 + ch] = a.x; Y[(t + 1) * 512 + ch] = a.y; }
        if (!samp) { if (tb == 63) { float* o = p.out + O_CAP + (size_t)b * 30 * 512 + ch;
#pragma unroll
                for (int i = 0; i < 30; ++i) o[i * 512] = g[32 + i]; } }
        else { float* o = p.out + O_CAS + (size_t)b * 30 * 512 + ch; const float* hs = p.in[IN_SCA] + (size_t)b * 30 * 512 + ch;
#pragma unroll
            for (int i = 0; i < 30; ++i) o[i * 512] = (i < 26) ? hs[(4 + i) * 512] : g[4 + i]; }
    }
    __syncthreads();
    {
        const int lane = c.lane, c0 = lane * 8; const int ntok = samp ? 4 : 32;
        const f32x4* lw = (const f32x4*)(p.in[IN_ELNW] + c0); const f32x4* lb = (const f32x4*)(p.in[IN_ELNB] + c0);
        const f32x4 w0 = lw[0], w1 = lw[1], b0 = lb[0], b1 = lb[1];
        for (int i = 0; i < 4; ++i) { const int t = c.wave * 4 + i; if (t >= ntok) break;
            const LAS f32x4* yp = (const LAS f32x4*)(Y + t * 512 + c0); const f32x4 y0 = yp[0], y1 = yp[1];
            const float mean = wave_sum((y0.x + y0.y) + (y0.z + y0.w) + (y1.x + y1.y) + (y1.z + y1.w)) * (1.f / 512.f);
            const f32x4 d0 = y0 - mean, d1 = y1 - mean;
            const float var = wave_sum((d0.x * d0.x + d0.y * d0.y) + (d0.z * d0.z + d0.w * d0.w) + (d1.x * d1.x + d1.y * d1.y) + (d1.z * d1.z + d1.w * d1.w)) * (1.f / 512.f);
            const float rstd = rsqrtf(var + EPS);
            const size_t row = samp ? (size_t)MP + 4 * b + t : (size_t)b * TP + t0 + t;
            const u32x4 gt = *(const u32x4*)(GATE + row * 1024 + c0);
            const f32x4 n0 = d0 * rstd * w0 + b0, n1 = d1 * rstd * w1 + b1;
            const float o[8] = {siluf_(n0.x) * bflo(gt.x), siluf_(n0.y) * bfhi(gt.x), siluf_(n0.z) * bflo(gt.y), siluf_(n0.w) * bfhi(gt.y),
                                siluf_(n1.x) * bflo(gt.z), siluf_(n1.y) * bfhi(gt.z), siluf_(n1.z) * bflo(gt.w), siluf_(n1.w) * bfhi(gt.w)};
            store_bf<8>(YCAT + row * 1024 + c0, o); }
    }
    __syncthreads();
}
__device__ __forceinline__ void kvq_row(const Params& p, const Ctx& c, int r) {
    unsigned char* ws = p.ws; const int lane = c.lane;
    const bf16* CQ = (const bf16*)(ws + WS_CQ); bf16* CQN = (bf16*)(ws + WS_CQN); const bf16* KV = (const bf16*)(ws + WS_KVRAW); bf16* KP = (bf16*)(ws + WS_KP);
    { const u32x2 t = *(const u32x2*)(CQ + (size_t)r * 256 + lane * 4); const float v0 = bflo(t.x), v1 = bfhi(t.x), v2 = bflo(t.y), v3 = bfhi(t.y);
      const float s = rsqrtf(wave_sum((v0 * v0 + v1 * v1) + (v2 * v2 + v3 * v3)) * (1.f / 256.f) + EPS); const f32x4 w = *(const f32x4*)(p.in[IN_EQN] + lane * 4);
      const float o[4] = {v0 * s * w.x, v1 * s * w.y, v2 * s * w.z, v3 * s * w.w}; store_bf<4>(CQN + (size_t)r * 256 + lane * 4, o); }
    float* ock = r < MP ? p.out + O_CKVP + (size_t)r * 128 : p.out + O_CKVS + (size_t)(r - MP) * 128;
    float* okr = r < MP ? p.out + O_KRP + (size_t)r * 32 : p.out + O_KRS + (size_t)(r - MP) * 32;
    { const unsigned t = *(const unsigned*)(KV + (size_t)r * 256 + lane * 2); const float v0 = bflo(t), v1 = bfhi(t);
      const float s = rsqrtf(wave_sum(v0 * v0 + v1 * v1) * (1.f / 128.f) + EPS); const f32x2 w = *(const f32x2*)(p.in[IN_EKVN] + lane * 2);
      const float o[2] = {v0 * s * w.x, v1 * s * w.y}; *(f32x2*)(ock + lane * 2) = (f32x2){o[0], o[1]}; store_bf<2>(KP + (size_t)r * 160 + lane * 2, o); }
    if (lane < 16) { const float x1 = bf2f(KV[(size_t)r * 256 + 128 + lane]), x2 = bf2f(KV[(size_t)r * 256 + 144 + lane]);
        const float* rp = (const float*)(ws + WS_ROPE) + ((size_t)pos_index(r) * 16 + lane) * 2; const float cs = rp[0], sn = rp[1];
        const float o[2] = {x1 * cs - x2 * sn, x1 * sn + x2 * cs}; okr[lane] = o[0]; okr[16 + lane] = o[1]; store_bf<2>(KP + (size_t)r * 160 + 128 + 2 * lane, o); }
}
__device__ __forceinline__ void phase_conv(const Params& p, const Ctx& c) {
    for (int u = c.cu; u < 512 + 32; u += c.G) conv_unit(p, c, u);
    for (int r = c.gw; r < MT; r += 2 * c.NGW) { kvq_row(p, c, r); if (r + c.NGW < MT) kvq_row(p, c, r + c.NGW); }
}
constexpr int KS = 336;
#define EXP2(x) __builtin_amdgcn_exp2f(x)
__device__ __forceinline__ void mla_prompt_unit(const Params& p, const Ctx& c, int b, int tb) {
    unsigned char* ws = p.ws;
    const bf16* QP = (const bf16*)(ws + WS_QP); const bf16* KP = (const bf16*)(ws + WS_KP); const bf16* GATE = (const bf16*)(ws + WS_GATE); bf16* YCAT = (bf16*)(ws + WS_YCAT);
    const bf16* WUVT = (const bf16*)(ws + WS_WUVT);
    const int tid = c.tid, lane = c.lane, r32 = lane & 31, hi = lane >> 5, head = c.wave, t0 = tb * 32;
    const size_t qrow = (size_t)b * TP + t0 + r32;
    bf16x8 qf[10];
#pragma unroll
    for (int s = 0; s < 8; ++s) qf[s] = *(const bf16x8*)(QP + qrow * 1280 + head * 128 + 16 * s + 8 * hi);
#pragma unroll
    for (int s = 0; s < 2; ++s) qf[8 + s] = *(const bf16x8*)(QP + qrow * 1280 + 1024 + head * 32 + 16 * s + 8 * hi);
    f32x16 o0 = {}, o1 = {}, o2 = {}, o3 = {}; float m = -1e30f, l = 0.f;
    const int ntile = (t0 + 32 + 63) >> 6;
    const bf16* kbase = KP + (size_t)b * TP * 160;
    u32x4 rg[3];
    const unsigned gvo = (unsigned)tid * 16u;
    const int lo0 = (tid / 20) * KS + (tid % 20) * 16, lo1 = ((tid + 512) / 20) * KS + ((tid + 512) % 20) * 16, lo2 = ((tid + 1024) / 20) * KS + ((tid + 1024) % 20) * 16;
#define MLA_LOAD(j) do { const char* t_ = (const char*)kbase + (size_t)(j) * 20480; rg[0] = *(const u32x4*)(t_ + gvo); rg[1] = *(const u32x4*)(t_ + gvo + 8192); if (tid < 256) rg[2] = *(const u32x4*)(t_ + gvo + 16384); } while (0)
#define MLA_STORE(buf) do { *(LAS u32x4*)((buf) + lo0) = rg[0]; *(LAS u32x4*)((buf) + lo1) = rg[1]; if (tid < 256) *(LAS u32x4*)((buf) + lo2) = rg[2]; } while (0)
    MLA_LOAD(0); MLA_STORE(c.lds); __syncthreads();
    const int vofs = (4 * hi + ((lane & 15) >> 2)) * KS + (((lane >> 4) & 1) * 16 + (lane & 3) * 4) * 2;
    for (int j = 0; j < ntile; ++j) {
        asm volatile("; MLA_TILE_BEGIN");
        LAS unsigned char* cur = c.lds + (j & 1) * (64 * KS); LAS unsigned char* nxt = c.lds + ((j + 1) & 1) * (64 * KS);
        if (j + 1 < ntile) MLA_LOAD(j + 1);
        const bool two = (64 * j + 32 <= t0 + 31);
        f32x16 p0 = {}, p1 = {};
        const LAS unsigned char* ka = cur + r32 * KS + hi * 16;
        { bf16x8 kf[10];
#pragma unroll
          for (int s = 0; s < 10; ++s) kf[s] = *(const LAS bf16x8*)(ka + s * 32);
          SCHED_FENCE(); PRIO_HI();
#pragma unroll
          for (int s = 0; s < 10; ++s) p0 = mfma32(kf[s], qf[s], p0);
          PRIO_LO(); SCHED_FENCE();
          if (two) {
#pragma unroll
            for (int s = 0; s < 10; ++s) kf[s] = *(const LAS bf16x8*)(ka + 32 * KS + s * 32);
            SCHED_FENCE(); PRIO_HI();
#pragma unroll
            for (int s = 0; s < 10; ++s) p1 = mfma32(kf[s], qf[s], p1);
            PRIO_LO(); SCHED_FENCE();
          } }
        if (64 * j + 63 > t0) { const int t = t0 + r32;
#pragma unroll
            for (int r = 0; r < 16; ++r) { const int key = 64 * j + crow(r, hi); if (key > t) p0[r] = -INFINITY; if (key + 32 > t) p1[r] = -INFINITY; } }
        float mx = max2f(p0[0], p1[0]);
#pragma unroll
        for (int r = 1; r < 16; ++r) mx = max3f(mx, p0[r], p1[r]);
        mx = max2f(mx, xhalf(mx));
        if (__builtin_amdgcn_ballot_w64(mx > m) != 0ull) {
            const float mn = max2f(m, mx), alpha = EXP2(m - mn); m = mn;
            l *= alpha; o0 *= alpha; o1 *= alpha; o2 *= alpha; o3 *= alpha;
        }
        float rs = 0.f;
#pragma unroll
        for (int r = 0; r < 16; ++r) { p0[r] = EXP2(p0[r] - m); p1[r] = EXP2(p1[r] - m); rs += p0[r] + p1[r]; }
        l += rs;
        const bf16x8 pf0 = pack8(p0[0], p0[1], p0[2], p0[3], p0[4], p0[5], p0[6], p0[7]), pf1 = pack8(p0[8], p0[9], p0[10], p0[11], p0[12], p0[13], p0[14], p0[15]);
        const bf16x8 pf2 = pack8(p1[0], p1[1], p1[2], p1[3], p1[4], p1[5], p1[6], p1[7]), pf3 = pack8(p1[8], p1[9], p1[10], p1[11], p1[12], p1[13], p1[14], p1[15]);
        const LAS unsigned char* va = cur + vofs;
#define MLA_PV(ks, pf) do { const LAS unsigned char* v_ = va + (16 * (ks)) * KS; \
            const s16x4 a0_ = tr_read(v_), a1_ = tr_read(v_ + 8 * KS), b0_ = tr_read(v_ + 64), b1_ = tr_read(v_ + 8 * KS + 64), c0_ = tr_read(v_ + 128), c1_ = tr_read(v_ + 8 * KS + 128), d0_ = tr_read(v_ + 192), d1_ = tr_read(v_ + 8 * KS + 192); \
            SCHED_FENCE(); PRIO_HI(); \
            o0 = mfma32(cat4(a0_, a1_), pf, o0); o1 = mfma32(cat4(b0_, b1_), pf, o1); o2 = mfma32(cat4(c0_, c1_), pf, o2); o3 = mfma32(cat4(d0_, d1_), pf, o3); \
            PRIO_LO(); SCHED_FENCE(); } while (0)
        MLA_PV(0, pf0); MLA_PV(1, pf1);
        if (two) { MLA_PV(2, pf2); MLA_PV(3, pf3); }
        if (j + 1 < ntile) MLA_STORE(nxt);
        __syncthreads();
        asm volatile("; MLA_TILE_END");
    }
    l += xhalf(l); const float inv = 1.f / l;
    o0 *= inv; o1 *= inv; o2 *= inv; o3 *= inv;
    f32x16 y0 = {}, y1 = {};
    const bf16* wp = WUVT + (size_t)head * 64 * 128 + r32 * 128 + 4 * hi;
#define MLA_UV(kc, of) do { const bf16* w_ = wp + 16 * (kc); const u32x2 a0_ = *(const u32x2*)w_, a1_ = *(const u32x2*)(w_ + 8), b0_ = *(const u32x2*)(w_ + 32 * 128), b1_ = *(const u32x2*)(w_ + 32 * 128 + 8); \
        const bf16x8 A0_ = __builtin_bit_cast(bf16x8, (u32x4){a0_.x, a0_.y, a1_.x, a1_.y}), A1_ = __builtin_bit_cast(bf16x8, (u32x4){b0_.x, b0_.y, b1_.x, b1_.y}); \
        y0 = mfma32(A0_, of, y0); y1 = mfma32(A1_, of, y1); } while (0)
#define PK_LO(o) pack8(o[0], o[1], o[2], o[3], o[4], o[5], o[6], o[7])
#define PK_HI(o) pack8(o[8], o[9], o[10], o[11], o[12], o[13], o[14], o[15])
    MLA_UV(0, PK_LO(o0)); MLA_UV(1, PK_HI(o0)); MLA_UV(2, PK_LO(o1)); MLA_UV(3, PK_HI(o1));
    MLA_UV(4, PK_LO(o2)); MLA_UV(5, PK_HI(o2)); MLA_UV(6, PK_LO(o3)); MLA_UV(7, PK_HI(o3));
    const size_t obase = qrow * 1024 + 512 + head * 64 + 4 * hi;
#pragma unroll
    for (int g = 0; g < 4; ++g) {
        { const u32x2 gt = *(const u32x2*)(GATE + obase + 8 * g); const float o[4] = {y0[4 * g] * bflo(gt.x), y0[4 * g + 1] * bfhi(gt.x), y0[4 * g + 2] * bflo(gt.y), y0[4 * g + 3] * bfhi(gt.y)}; store_bf<4>(YCAT + obase + 8 * g, o); }
        { const u32x2 gt = *(const u32x2*)(GATE + obase + 32 + 8 * g); const float o[4] = {y1[4 * g] * bflo(gt.x), y1[4 * g + 1] * bfhi(gt.x), y1[4 * g + 2] * bflo(gt.y), y1[4 * g + 3] * bfhi(gt.y)}; store_bf<4>(YCAT + obase + 32 + 8 * g, o); }
    }
}
__device__ __forceinline__ void mla_sample_wave(const Params& p, const Ctx& c, int b, int sp) {
    unsigned char* ws = p.ws;
    const bf16* QP = (const bf16*)(ws + WS_QP); const bf16* KP = (const bf16*)(ws + WS_KP); float* PART = (float*)(ws + WS_PART);
    const int lane = c.lane, r32 = lane & 31, hi = lane >> 5, head = r32 & 7, tok = r32 >> 3;
    const size_t qrow = (size_t)MP + 4 * b + tok;
    bf16x8 qf[10];
#pragma unroll
    for (int s = 0; s < 8; ++s) qf[s] = *(const bf16x8*)(QP + qrow * 1280 + head * 128 + 16 * s + 8 * hi);
#pragma unroll
    for (int s = 0; s < 2; ++s) qf[8 + s] = *(const bf16x8*)(QP + qrow * 1280 + 1024 + head * 32 + 16 * s + 8 * hi);
    f32x16 o0 = {}, o1 = {}, o2 = {}, o3 = {}; float m = -1e30f, l = 0.f;
    LAS unsigned char* buf = c.lds + c.wave * (32 * KS);
    const int* pt = (const int*)p.in[IN_PT] + b * 128;
    const int ntile = (sp == 63) ? 9 : 8;
    const int vofs = (4 * hi + ((lane & 15) >> 2)) * KS + (((lane >> 4) & 1) * 16 + (lane & 3) * 4) * 2;
    for (int j = 0; j < ntile; ++j) {
        if (j < 8) {
            const int key0 = 256 * sp + 32 * j; const size_t prow = (size_t)pt[key0 >> 7] * 128 + (key0 & 127);
            const f32x4* sc = (const f32x4*)(p.in[IN_CCKV] + prow * 128);
            { const f32x4* sp_ = sc + lane; LAS unsigned char* dp_ = buf + (lane >> 5) * KS + (lane & 31) * 8;
#pragma unroll 4
              for (int i = 0; i < 16; ++i) { const f32x4 v = __builtin_nontemporal_load(sp_ + 64 * i); u32x2 w; w.x = pk2(v.x, v.y); w.y = pk2(v.z, v.w); *(LAS u32x2*)(dp_ + i * 2 * KS) = w; } }
            const float* sr = p.in[IN_CKR] + prow * 32;
#pragma unroll
            for (int i = 0; i < 2; ++i) { const int cmb = lane + 64 * i, row = cmb >> 2, i4 = cmb & 3; const f32x4 x1 = ldnt4(sr + row * 32 + 4 * i4), x2 = ldnt4(sr + row * 32 + 16 + 4 * i4);
                u32x4 w; w.x = pk2(x1.x, x2.x); w.y = pk2(x1.y, x2.y); w.z = pk2(x1.z, x2.z); w.w = pk2(x1.w, x2.w); *(LAS u32x4*)(buf + row * KS + 256 + i4 * 16) = w; }
        } else {
            { LAS u32x4* zp = (LAS u32x4*)buf + lane;
#pragma unroll
              for (int i = 0; i < 11; ++i) if (lane + 64 * i < 672) zp[64 * i] = (u32x4){0u, 0u, 0u, 0u}; }
            LDS_WAIT();
            { const bf16* src = KP + ((size_t)MP + 4 * b) * 160;
              const int r0 = lane / 20, c0 = lane - 20 * r0; *(LAS u32x4*)(buf + r0 * KS + c0 * 16) = *(const u32x4*)(src + lane * 8);
              if (lane < 16) { const int ch = 64 + lane, r1 = 3, c1 = ch - 60; *(LAS u32x4*)(buf + r1 * KS + c1 * 16) = *(const u32x4*)(src + ch * 8); } }
        }
        LDS_WAIT();
        f32x16 p0 = {};
        const LAS unsigned char* ka = buf + r32 * KS + hi * 16;
        { bf16x8 kf[10];
#pragma unroll
          for (int s = 0; s < 10; ++s) kf[s] = *(const LAS bf16x8*)(ka + s * 32);
          SCHED_FENCE();
#pragma unroll
          for (int s = 0; s < 10; ++s) p0 = mfma32(kf[s], qf[s], p0);
          SCHED_FENCE(); }
        if (j == 8) {
#pragma unroll
            for (int r = 0; r < 16; ++r) { const int key = crow(r, hi); if (key > tok) p0[r] = -INFINITY; }
        }
        float mx = max3f(p0[0], p0[1], p0[2]);
#pragma unroll
        for (int r = 3; r < 15; r += 2) mx = max3f(mx, p0[r], p0[r + 1]);
        mx = max2f(mx, p0[15]);
        mx = max2f(mx, xhalf(mx));
        if (__builtin_amdgcn_ballot_w64(mx > m) != 0ull) {
            const float mn = max2f(m, mx), alpha = EXP2(m - mn); m = mn;
            l *= alpha; o0 *= alpha; o1 *= alpha; o2 *= alpha; o3 *= alpha;
        }
        float rs = 0.f;
#pragma unroll
        for (int r = 0; r < 16; ++r) { p0[r] = EXP2(p0[r] - m); rs += p0[r]; }
        l += rs;
        const bf16x8 pf0 = pack8(p0[0], p0[1], p0[2], p0[3], p0[4], p0[5], p0[6], p0[7]), pf1 = pack8(p0[8], p0[9], p0[10], p0[11], p0[12], p0[13], p0[14], p0[15]);
        const LAS unsigned char* va = buf + vofs;
        MLA_PV(0, pf0); MLA_PV(1, pf1);
        LDS_WAIT();
    }
    l += xhalf(l);
    float* po = PART + ((size_t)b * 64 + sp) * PART_STRIDE + (unsigned)lane;
#pragma unroll
    for (int r = 0; r < 16; ++r) { po[r * 64] = o0[r]; po[1024 + r * 64] = o1[r]; po[2048 + r * 64] = o2[r]; po[3072 + r * 64] = o3[r]; }
    if (lane < 32) { po[4096] = m; po[4096 + 32] = l; }
}
__device__ __forceinline__ void phase_mla(const Params& p, const Ctx& c) {
    const bool sfirst = (c.cu & 1) != 0;
    if (sfirst) { for (int u = c.cu; u < 256; u += c.G) mla_sample_wave(p, c, u >> 3, (u & 7) * 8 + c.wave); __syncthreads(); }
    for (int i = c.cu; i < 512; i += c.G) { const int k = (i < 256) ? i : 767 - i;
        mla_prompt_unit(p, c, k & 7, 63 - (k >> 3)); }
    __syncthreads();
    if (!sfirst) { for (int u = c.cu; u < 256; u += c.G) mla_sample_wave(p, c, u >> 3, (u & 7) * 8 + c.wave); __syncthreads(); }
}
__device__ __forceinline__ void mla_combine_unit(const Params& p, const Ctx& c, int b) {
    unsigned char* ws = p.ws; const float* PART = (const float*)(ws + WS_PART) + (size_t)b * 64 * PART_STRIDE;
    const bf16* GATE = (const bf16*)(ws + WS_GATE); bf16* YCAT = (bf16*)(ws + WS_YCAT);
    LAS float* OS = (LAS float*)c.lds;
    const int tid = c.tid, q = tid & 31;
    float M = -1e30f;
#pragma unroll 16
    for (int s = 0; s < 64; ++s) M = fmaxf(M, PART[(size_t)s * PART_STRIDE + 4096 + q]);
    float L = 0.f, acc[8] = {0.f, 0.f, 0.f, 0.f, 0.f, 0.f, 0.f, 0.f};
#pragma unroll 1
    for (int s0 = 0; s0 < 64; s0 += 8) {
        float ms[8], ls[8], ov[8][8];
#pragma unroll
        for (int j = 0; j < 8; ++j) { const float* ps = PART + (size_t)(s0 + j) * PART_STRIDE; ms[j] = ps[4096 + q]; ls[j] = ps[4096 + 32 + q];
#pragma unroll
            for (int i = 0; i < 8; ++i) ov[j][i] = ps[tid + 512 * i]; }
#pragma unroll
        for (int j = 0; j < 8; ++j) { const float w = EXP2(ms[j] - M); L += w * ls[j];
#pragma unroll
            for (int i = 0; i < 8; ++i) acc[i] += w * ov[j][i]; }
    }
    const float inv = 1.f / L;
#pragma unroll
    for (int i = 0; i < 8; ++i) { const int e = tid + 512 * i, dbr = e >> 6, ln = e & 63; const int cc = 32 * (dbr >> 4) + crow(dbr & 15, ln >> 5); OS[q * 129 + cc] = acc[i] * inv; }
    __syncthreads();
    { const int qq = tid >> 4, v0 = (tid & 15) * 4, head = qq & 7, tok = qq >> 3; const float* wuv = p.in[IN_EWUV];
      float y[4] = {0.f, 0.f, 0.f, 0.f};
      for (int cc = 0; cc < 128; ++cc) { const float ov = OS[qq * 129 + cc]; const f32x4 w = *(const f32x4*)(wuv + ((size_t)cc * 8 + head) * 64 + v0); y[0] += ov * w.x; y[1] += ov * w.y; y[2] += ov * w.z; y[3] += ov * w.w; }
      const size_t ob = ((size_t)MP + 4 * b + tok) * 1024 + 512 + head * 64 + v0; const u32x2 gt = *(const u32x2*)(GATE + ob);
      const float o[4] = {y[0] * bflo(gt.x), y[1] * bfhi(gt.x), y[2] * bflo(gt.y), y[3] * bfhi(gt.y)}; store_bf<4>(YCAT + ob, o); }
    __syncthreads();
}
constexpr int XS = 528;
constexpr int XV = 576;
template <bool samp> __device__ __forceinline__ void xattn_unit(const Params& p, const Ctx& c, int layer, int b, int h, int qb, int dh_lo, int dh_hi) {
    unsigned char* ws = p.ws;
    const bf16* XQ = (const bf16*)(ws + WS_XQ); const bf16* XG = (const bf16*)(ws + WS_XG); bf16* XO = (bf16*)(ws + WS_XO);
    const int tid = c.tid, lane = c.lane, r32 = lane & 31, hi = lane >> 5;
    const size_t row = samp ? (size_t)MP + 4 * b + (r32 & 3) : (size_t)b * TP + qb * 256 + c.wave * 32 + r32;
    const bool active = !samp || c.wave == 0;
    const bf16* kb16 = (const bf16*)(ws + WS_MKV) + ((size_t)(layer * 2 + 0) * 2048 + (size_t)b * 256) * 1024 + h * 256;
    const bf16* vb16 = (const bf16*)(ws + WS_MKV) + ((size_t)(layer * 2 + 1) * 2048 + (size_t)b * 256) * 1024 + h * 256;
    const float* kf32 = p.in[IN_CMK] + ((size_t)(layer * 32 + b) * 256) * 1024 + h * 256;
    const float* vf32 = p.in[IN_CMV] + ((size_t)(layer * 32 + b) * 256) * 1024 + h * 256;
    u32x4 rgk[4], rgv[4];
    const unsigned voff = (unsigned)((tid >> 5) * 1024 + (tid & 31) * 8);
    const unsigned loff = (unsigned)((tid >> 5) * XS + (tid & 31) * 16), loffv = (unsigned)((tid >> 5) * XV + (tid & 31) * 16);
#define XA_LOAD(rg, p16, kt) do { if (!samp) { const bf16* t_ = (p16) + (size_t)(64 * (kt)) * 1024; \
            _Pragma("unroll") for (int i_ = 0; i_ < 4; ++i_) rg[i_] = *(const u32x4*)(t_ + (size_t)i_ * 16 * 1024 + voff); } } while (0)
#define XA_STORE(buf, lo_, st_, rg, p32, kt) do { if (!samp) { _Pragma("unroll") for (int i_ = 0; i_ < 4; ++i_) *(LAS u32x4*)((buf) + (lo_) + i_ * 16 * (st_)) = rg[i_]; } \
        else { const float* t_ = (p32) + (size_t)(64 * (kt)) * 1024 + voff;        \
            f32x4 a_[4], d_[4]; _Pragma("unroll") for (int i_ = 0; i_ < 4; ++i_) { const f32x4* s_ = (const f32x4*)(t_ + (size_t)i_ * 16 * 1024); a_[i_] = __builtin_nontemporal_load(s_); d_[i_] = __builtin_nontemporal_load(s_ + 1); } \
            _Pragma("unroll") for (int i_ = 0; i_ < 4; ++i_) *(LAS u32x4*)((buf) + (lo_) + i_ * 16 * (st_)) = (u32x4){pk2(a_[i_].x, a_[i_].y), pk2(a_[i_].z, a_[i_].w), pk2(d_[i_].x, d_[i_].y), pk2(d_[i_].z, d_[i_].w)}; } } while (0)
    LAS unsigned char* kbuf = c.lds; LAS unsigned char* vbuf = c.lds + 64 * XS;
    bf16x8 qf[16];
#pragma unroll
    for (int s = 0; s < 16; ++s) qf[s] = *(const bf16x8*)(XQ + row * 1024 + h * 256 + 16 * s + 8 * hi);
    const int vofs = (4 * hi + ((lane & 15) >> 2)) * XV + (((lane >> 4) & 1) * 16 + (lane & 3) * 4) * 2;
    const LAS unsigned char* ka = kbuf + r32 * XS + hi * 16;
#pragma unroll 1
    for (int dh = dh_lo; dh < dh_hi; ++dh) {
        f32x16 o0 = {}, o1 = {}, o2 = {}, o3 = {}; float m = -1e30f, l = 0.f;
        XA_LOAD(rgk, kb16, 0); XA_LOAD(rgv, vb16, 0);
#pragma unroll 1
        for (int kt = 0; kt < 4; ++kt) {
            __syncthreads();
            XA_STORE(kbuf, loff, XS, rgk, kf32, kt); XA_STORE(vbuf, loffv, XV, rgv, vf32, kt);
            __syncthreads();
            if (kt < 3) { XA_LOAD(rgk, kb16, kt + 1); XA_LOAD(rgv, vb16, kt + 1); }
            if (active) {
                f32x16 p0 = {}, p1 = {};
#pragma unroll
                for (int s2 = 0; s2 < 8; ++s2) { bf16x8 ka_[2], kb_[2];
#pragma unroll
                    for (int j = 0; j < 2; ++j) { ka_[j] = *(const LAS bf16x8*)(ka + (2 * s2 + j) * 32); kb_[j] = *(const LAS bf16x8*)(ka + 32 * XS + (2 * s2 + j) * 32); }
                    SCHED_FENCE();
#pragma unroll
                    for (int j = 0; j < 2; ++j) { p0 = mfma32(ka_[j], qf[2 * s2 + j], p0); p1 = mfma32(kb_[j], qf[2 * s2 + j], p1); }
                    SCHED_FENCE(); }
                float mx = fmaxf(p0[0], p1[0]);
#pragma unroll
                for (int r = 1; r < 16; ++r) mx = fmaxf(mx, fmaxf(p0[r], p1[r]));
                mx = fmaxf(mx, xhalf(mx));
                const float mn = fmaxf(m, mx), alpha = EXP2(m - mn); m = mn;
                float rs = 0.f;
#pragma unroll
                for (int r = 0; r < 16; ++r) { p0[r] = EXP2(p0[r] - mn); p1[r] = EXP2(p1[r] - mn); rs += p0[r] + p1[r]; }
                l = l * alpha + rs;
                o0 *= alpha; o1 *= alpha; o2 *= alpha; o3 *= alpha;
                const bf16x8 pf0 = pack8(p0[0], p0[1], p0[2], p0[3], p0[4], p0[5], p0[6], p0[7]), pf1 = pack8(p0[8], p0[9], p0[10], p0[11], p0[12], p0[13], p0[14], p0[15]);
                const bf16x8 pf2 = pack8(p1[0], p1[1], p1[2], p1[3], p1[4], p1[5], p1[6], p1[7]), pf3 = pack8(p1[8], p1[9], p1[10], p1[11], p1[12], p1[13], p1[14], p1[15]);
                const LAS unsigned char* va = vbuf + vofs + dh * 256;
#define XA_PV(ks, pf) do { const LAS unsigned char* v_ = va + (16 * (ks)) * XV; \
                    const s16x4 a0_ = tr_read(v_), a1_ = tr_read(v_ + 8 * XV), b0_ = tr_read(v_ + 64), b1_ = tr_read(v_ + 8 * XV + 64), c0_ = tr_read(v_ + 128), c1_ = tr_read(v_ + 8 * XV + 128), d0_ = tr_read(v_ + 192), d1_ = tr_read(v_ + 8 * XV + 192); \
                    SCHED_FENCE(); PRIO_HI(); \
                    o0 = mfma32(cat4(a0_, a1_), pf, o0); o1 = mfma32(cat4(b0_, b1_), pf, o1); o2 = mfma32(cat4(c0_, c1_), pf, o2); o3 = mfma32(cat4(d0_, d1_), pf, o3); \
                    PRIO_LO(); SCHED_FENCE(); } while (0)
                XA_PV(0, pf0); XA_PV(1, pf1); XA_PV(2, pf2); XA_PV(3, pf3);
            }
        }
        if (active && (!samp || r32 < 4)) {
            l += xhalf(l);
            const float inv = 1.f / l; const size_t ob = row * 1024 + h * 256 + dh * 128 + 4 * hi;
#define XA_OUT(db, o) do { _Pragma("unroll") for (int g = 0; g < 4; ++g) { const size_t a = ob + 32 * (db) + 8 * g; const u32x2 gt = *(const u32x2*)(XG + a); \
                const float ov[4] = {o[4 * g] * inv * bflo(gt.x), o[4 * g + 1] * inv * bfhi(gt.x), o[4 * g + 2] * inv * bflo(gt.y), o[4 * g + 3] * inv * bfhi(gt.y)}; store_bf<4>(XO + a, ov); } } while (0)
            XA_OUT(0, o0); XA_OUT(1, o1); XA_OUT(2, o2); XA_OUT(3, o3);
        }
    }
    __syncthreads();
}
__device__ __forceinline__ void xattn_prompt_unit(const Params& p, const Ctx& c, int layer, int b, int h, int qb) {
    unsigned char* ws = p.ws;
    const bf16* XQ = (const bf16*)(ws + WS_XQ); const bf16* XG = (const bf16*)(ws + WS_XG); bf16* XO = (bf16*)(ws + WS_XO);
    const int tid = c.tid, lane = c.lane, r32 = lane & 31, hi = lane >> 5;
    const size_t row = (size_t)b * TP + qb * 256 + c.wave * 32 + r32;
    const bf16* kb16 = (const bf16*)(ws + WS_MKV) + ((size_t)(layer * 2 + 0) * 2048 + (size_t)b * 256) * 1024 + h * 256;
    const bf16* vb16 = (const bf16*)(ws + WS_MKV) + ((size_t)(layer * 2 + 1) * 2048 + (size_t)b * 256) * 1024 + h * 256;
    u32x4 rg[4];
    const unsigned voff = (unsigned)((tid >> 5) * 1024 + (tid & 31) * 8);
    const unsigned loff = (unsigned)((tid >> 5) * XS + (tid & 31) * 16), loffv = (unsigned)((tid >> 5) * XV + (tid & 31) * 16);
#define XP_LOAD(p16, kt) do { const bf16* t_ = (p16) + (size_t)(64 * (kt)) * 1024; _Pragma("unroll") for (int i_ = 0; i_ < 4; ++i_) rg[i_] = *(const u32x4*)(t_ + (size_t)i_ * 16 * 1024 + voff); } while (0)
#define XP_STORE(buf, lo_, st_) do { _Pragma("unroll") for (int i_ = 0; i_ < 4; ++i_) *(LAS u32x4*)((buf) + (lo_) + i_ * 16 * (st_)) = rg[i_]; } while (0)
    LAS unsigned char* kbuf = c.lds; LAS unsigned char* vbuf = c.lds + 64 * XS;
    bf16x8 pf[16]; float mk0 = 0.f, mk1 = 0.f, mk2 = 0.f, m = -1e30f, l = 0.f;
    XP_LOAD(kb16, 0);
    {
        bf16x8 qf[16];
#pragma unroll
        for (int s = 0; s < 16; ++s) qf[s] = *(const bf16x8*)(XQ + row * 1024 + h * 256 + 16 * s + 8 * hi);
        const LAS unsigned char* ka = kbuf + r32 * XS + hi * 16;
#pragma unroll
        for (int kt = 0; kt < 4; ++kt) {
            __syncthreads();
            XP_STORE(kbuf, loff, XS);
            __syncthreads();
            if (kt < 3) XP_LOAD(kb16, kt + 1); else XP_LOAD(vb16, 0);
            f32x16 p0 = {}, p1 = {};
#pragma unroll
            for (int s2 = 0; s2 < 8; ++s2) { bf16x8 ka_[2], kb_[2];
#pragma unroll
                for (int j = 0; j < 2; ++j) { ka_[j] = *(const LAS bf16x8*)(ka + (2 * s2 + j) * 32); kb_[j] = *(const LAS bf16x8*)(ka + 32 * XS + (2 * s2 + j) * 32); }
                SCHED_FENCE(); PRIO_HI();
#pragma unroll
                for (int j = 0; j < 2; ++j) { p0 = mfma32(ka_[j], qf[2 * s2 + j], p0); p1 = mfma32(kb_[j], qf[2 * s2 + j], p1); }
                PRIO_LO(); SCHED_FENCE(); }
            float mx = fmaxf(p0[0], p1[0]);
#pragma unroll
            for (int r = 1; r < 16; ++r) mx = fmaxf(mx, fmaxf(p0[r], p1[r]));
            mx = fmaxf(mx, xhalf(mx));
            const float mn = fmaxf(m, mx); l *= EXP2(m - mn); m = mn;
            if (kt == 0) mk0 = mn; else if (kt == 1) mk1 = mn; else if (kt == 2) mk2 = mn;
            float rs = 0.f;
#pragma unroll
            for (int r = 0; r < 16; ++r) { p0[r] = EXP2(p0[r] - mn); p1[r] = EXP2(p1[r] - mn); rs += p0[r] + p1[r]; }
            l += rs;
            pf[4 * kt + 0] = pack8(p0[0], p0[1], p0[2], p0[3], p0[4], p0[5], p0[6], p0[7]); pf[4 * kt + 1] = pack8(p0[8], p0[9], p0[10], p0[11], p0[12], p0[13], p0[14], p0[15]);
            pf[4 * kt + 2] = pack8(p1[0], p1[1], p1[2], p1[3], p1[4], p1[5], p1[6], p1[7]); pf[4 * kt + 3] = pack8(p1[8], p1[9], p1[10], p1[11], p1[12], p1[13], p1[14], p1[15]);
        }
    }
    l += xhalf(l);
    { const float inv = 1.f / l;
#pragma unroll
      for (int i = 0; i < 16; ++i) { const float f = (i < 4 ? EXP2(mk0 - m) : i < 8 ? EXP2(mk1 - m) : i < 12 ? EXP2(mk2 - m) : 1.f) * inv; u32x4 w = __builtin_bit_cast(u32x4, pf[i]);
          w.x = pk2(bflo(w.x) * f, bfhi(w.x) * f); w.y = pk2(bflo(w.y) * f, bfhi(w.y) * f); w.z = pk2(bflo(w.z) * f, bfhi(w.z) * f); w.w = pk2(bflo(w.w) * f, bfhi(w.w) * f); pf[i] = __builtin_bit_cast(bf16x8, w); } }
    const int vofs = (4 * hi + ((lane & 15) >> 2)) * XV + (((lane >> 4) & 1) * 16 + (lane & 3) * 4) * 2;
#pragma unroll
    for (int dh = 0; dh < 2; ++dh) {
        f32x16 o0 = {}, o1 = {}, o2 = {}, o3 = {};
#pragma unroll
        for (int vt = 0; vt < 4; ++vt) {
            __syncthreads();
            XP_STORE(vbuf, loffv, XV);
            __syncthreads();
            if (vt < 3) XP_LOAD(vb16, vt + 1); else if (dh == 0) XP_LOAD(vb16, 0);
            const LAS unsigned char* va = vbuf + vofs + dh * 256;
            XA_PV(0, pf[4 * vt + 0]); XA_PV(1, pf[4 * vt + 1]); XA_PV(2, pf[4 * vt + 2]); XA_PV(3, pf[4 * vt + 3]);
        }
        const float inv = 1.f; const size_t ob = row * 1024 + h * 256 + dh * 128 + 4 * hi;
        XA_OUT(0, o0); XA_OUT(1, o1); XA_OUT(2, o2); XA_OUT(3, o3);
    }
    __syncthreads();
}
__device__ __forceinline__ void phase_xattn(const Params& p, const Ctx& c, int layer) {
    const int vcu = (c.G % 8 == 0) ? (c.cu & 7) * (c.G >> 3) + (c.cu >> 3) : c.cu;
    for (int u = vcu; u < 256; u += c.G) xattn_prompt_unit(p, c, layer, u >> 5, (u >> 3) & 3, u & 7);
    for (int s = vcu; s < 256; s += c.G) xattn_unit<true>(p, c, layer, s >> 3, (s >> 1) & 3, 0, s & 1, (s & 1) + 1);
}
__device__ __forceinline__ void phase_conv4(const Params& p, const Ctx& c) {
    unsigned char* ws = p.ws; const bf16* XBC = (const bf16*)(ws + WS_XBC); bf16* XBCC = (bf16*)(ws + WS_XBCC);
    const float* cw = p.in[IN_OCW]; const float* cb = p.in[IN_OCB];
    const int gt = c.gw * 64 + c.lane, NGT = c.NGW * 64;
    for (int idx = gt; idx < (MP / 8) * 384; idx += NGT) {
        const int rg = idx / 384, c8 = idx % 384, row0 = rg * 8, t0 = row0 & (TP - 1), ch = c8 * 8;
        float w[4][8], bias[8];
#pragma unroll
        for (int k = 0; k < 4; ++k) { const f32x4 a = *(const f32x4*)(cw + k * 3072 + ch), d = *(const f32x4*)(cw + k * 3072 + ch + 4); w[k][0] = a.x; w[k][1] = a.y; w[k][2] = a.z; w[k][3] = a.w; w[k][4] = d.x; w[k][5] = d.y; w[k][6] = d.z; w[k][7] = d.w; }
        { const f32x4 a = *(const f32x4*)(cb + ch), d = *(const f32x4*)(cb + ch + 4); bias[0] = a.x; bias[1] = a.y; bias[2] = a.z; bias[3] = a.w; bias[4] = d.x; bias[5] = d.y; bias[6] = d.z; bias[7] = d.w; }
        u32x4 x[11];
#pragma unroll
        for (int i = 0; i < 11; ++i) { x[i] = (u32x4){0u, 0u, 0u, 0u}; if (t0 + i - 3 >= 0) x[i] = *(const u32x4*)(XBC + (size_t)(row0 + i - 3) * 3072 + ch); }
#pragma unroll
        for (int t = 0; t < 8; ++t) { float a[8];
#pragma unroll
            for (int e = 0; e < 8; ++e) a[e] = bias[e];
#pragma unroll
            for (int k = 0; k < 4; ++k) { const u32x4 v = x[t + k]; a[0] = fmaf(w[k][0], bflo(v.x), a[0]); a[1] = fmaf(w[k][1], bfhi(v.x), a[1]); a[2] = fmaf(w[k][2], bflo(v.y), a[2]); a[3] = fmaf(w[k][3], bfhi(v.y), a[3]);
                a[4] = fmaf(w[k][4], bflo(v.z), a[4]); a[5] = fmaf(w[k][5], bfhi(v.z), a[5]); a[6] = fmaf(w[k][6], bflo(v.w), a[6]); a[7] = fmaf(w[k][7], bfhi(v.w), a[7]); }
#pragma unroll
            for (int e = 0; e < 8; ++e) a[e] = siluf_(a[e]);
            store_bf<8>(XBCC + (size_t)(row0 + t) * 3072 + ch, a); }
        if (t0 == TP - 8) { float* o = p.out + O_CCP + (size_t)(row0 >> 11) * 3 * 3072 + ch;
#pragma unroll
            for (int i = 0; i < 3; ++i) { const u32x4 v = x[8 + i]; *(f32x4*)(o + i * 3072) = (f32x4){bflo(v.x), bfhi(v.x), bflo(v.y), bfhi(v.y)}; *(f32x4*)(o + i * 3072 + 4) = (f32x4){bflo(v.z), bfhi(v.z), bflo(v.w), bfhi(v.w)}; } }
    }
    for (int idx = gt; idx < NBS * 384; idx += NGT) {
        const int b = idx / 384, c8 = idx % 384, ch = c8 * 8; const size_t row0 = (size_t)MP + 4 * b;
        float xe[7][8];
#pragma unroll
        for (int i = 0; i < 3; ++i) { const float* s = p.in[IN_SCC] + ((size_t)b * 3 + i) * 3072 + ch; const f32x4 a = *(const f32x4*)s, d = *(const f32x4*)(s + 4); xe[i][0] = a.x; xe[i][1] = a.y; xe[i][2] = a.z; xe[i][3] = a.w; xe[i][4] = d.x; xe[i][5] = d.y; xe[i][6] = d.z; xe[i][7] = d.w; }
#pragma unroll
        for (int i = 0; i < 4; ++i) { const u32x4 v = *(const u32x4*)(XBC + (row0 + i) * 3072 + ch); xe[3 + i][0] = bflo(v.x); xe[3 + i][1] = bfhi(v.x); xe[3 + i][2] = bflo(v.y); xe[3 + i][3] = bfhi(v.y); xe[3 + i][4] = bflo(v.z); xe[3 + i][5] = bfhi(v.z); xe[3 + i][6] = bflo(v.w); xe[3 + i][7] = bfhi(v.w); }
#pragma unroll
        for (int t = 0; t < 4; ++t) { float a[8];
#pragma unroll
            for (int e = 0; e < 8; ++e) { float s = cb[ch + e];
#pragma unroll
                for (int k = 0; k < 4; ++k) s = fmaf(cw[k * 3072 + ch + e], xe[t + k][e], s);
                a[e] = siluf_(s); }
            store_bf<8>(XBCC + (row0 + t) * 3072 + ch, a); }
        float* o = p.out + O_CCS + (size_t)b * 3 * 3072 + ch;
#pragma unroll
        for (int i = 0; i < 3; ++i) { *(f32x4*)(o + i * 3072) = (f32x4){xe[4 + i][0], xe[4 + i][1], xe[4 + i][2], xe[4 + i][3]}; *(f32x4*)(o + i * 3072 + 4) = (f32x4){xe[4 + i][4], xe[4 + i][5], xe[4 + i][6], xe[4 + i][7]}; }
    }
}

constexpr int BSS = 272, XSS = 144;
constexpr int L_BS = 0, L_CS = 128 * 256, L_XS = L_CS + 128 * BSS, L_XD = L_XS + 128 * XSS, L_SB = L_XD + 128 * XSS, L_CUM = L_SB + 64 * BSS, L_DTV = L_CUM + 512, L_YT = L_DTV + 512, L_SSD_END = L_YT + 128 * XSS;
static_assert(L_SSD_END <= MISC_OFF, "ssd lds");
__device__ __forceinline__ int bs_f(int r) { return ((r & 3) << 2) | ((r >> 2) & 3); }
__device__ __forceinline__ void ssd_prompt_unit(const Params& p, const Ctx& c, int b, int hd) {
    unsigned char* ws = p.ws;
    const bf16* XB = (const bf16*)(ws + WS_XBCC); const bf16* ZS = (const bf16*)(ws + WS_ZS); const float* DT = (const float*)(ws + WS_DT); bf16* YZ = (bf16*)(ws + WS_YZ);
    const int tid = c.tid, lane = c.lane, r32 = lane & 31, hi = lane >> 5, w = c.wave, pb = w >> 2, tb = pb ? 3 - (w & 3) : (w & 3), g = hd >> 3;
    const float a_h = -__expf(p.in[IN_OALOG][hd]), d_h = p.in[IN_OD][hd];
    LAS unsigned char* L = c.lds;
    LAS float* CUM = (LAS float*)(L + L_CUM); LAS float* DTV = (LAS float*)(L + L_DTV);
    f32x16 st = {};
    const int trofs = ((lane & 15) >> 2);
    const int trcol = (((lane >> 4) & 1) * 16 + (lane & 3) * 4) * 2;
    u32x4 rb[4], rc[4], rx[2]; float d0 = 0.f, d1 = 0.f;
    const bf16* bbase = XB + (size_t)b * TP * 3072 + 2048 + g * 128; const bf16* xbase = XB + (size_t)b * TP * 3072 + hd * 64;
    const bf16* zbase = ZS + (size_t)b * TP * 2048 + hd * 64; const float* dbase = DT + (size_t)b * TP * 32 + hd;
    const unsigned bo = (unsigned)((tid >> 4) * 3072 + (tid & 15) * 8), xo = (unsigned)((tid >> 3) * 3072 + (tid & 7) * 8), zo = (unsigned)((tid >> 3) * 2048 + (tid & 7) * 8), dof = (unsigned)(2 * lane * 32);
#define SSD_LOAD(ck_) do { const bf16* bb_ = bbase + (size_t)(128 * (ck_)) * 3072; const bf16* xb_ = xbase + (size_t)(128 * (ck_)) * 3072; \
        _Pragma("unroll") for (int i_ = 0; i_ < 4; ++i_) { rb[i_] = *(const u32x4*)(bb_ + (size_t)i_ * 32 * 3072 + bo); rc[i_] = *(const u32x4*)(bb_ + (size_t)i_ * 32 * 3072 + 512 + bo); } \
        _Pragma("unroll") for (int i_ = 0; i_ < 2; ++i_) rx[i_] = *(const u32x4*)(xb_ + (size_t)i_ * 64 * 3072 + xo); \
        if (w == 0) { const float* db_ = dbase + (size_t)(128 * (ck_)) * 32; d0 = db_[dof]; d1 = db_[dof + 32]; } } while (0)
    SSD_LOAD(0);
    const int lbc = (tid >> 4) * BSS + (tid & 15) * 16, lx = (tid >> 3) * XSS + (tid & 7) * 16;
    const int lbs = (tid >> 4) * 256 + 16 * ((tid & 15) ^ bs_f(tid >> 4));
    const int fs_row = bs_f(r32);
    const int f_lo = (trofs << 2) | (2 * hi), f_hi = (trofs << 2) | (2 * hi + 1);
#pragma unroll 1
    for (int ck = 0; ck < 16; ++ck) {
        asm volatile("; SSD_CHUNK_BEGIN");
        const size_t row0 = (size_t)b * TP + 128 * ck;
        __syncthreads();
        if (w == 0) { const float v0 = a_h * LOG2E * d0, v1 = a_h * LOG2E * d1; float s = v0 + v1;
#pragma unroll
            for (int o = 1; o < 64; o <<= 1) { const float t = __shfl_up(s, o); if (lane >= o) s += t; }
            CUM[2 * lane] = s - v1; CUM[2 * lane + 1] = s; DTV[2 * lane] = (s - v1) - __builtin_amdgcn_logf(d0); DTV[2 * lane + 1] = s - __builtin_amdgcn_logf(d1); }
#pragma unroll
        for (int i = 0; i < 4; ++i) { *(LAS u32x4*)(L + L_BS + lbs + i * 32 * 256) = rb[i]; *(LAS u32x4*)(L + L_CS + lbc + i * 32 * BSS) = rc[i]; }
#pragma unroll
        for (int i = 0; i < 2; ++i) *(LAS u32x4*)(L + L_XS + lx + i * 64 * XSS) = rx[i];
#pragma unroll
        for (int r = 0; r < 16; ++r) *(LAS unsigned short*)(L + L_SB + (32 * pb + crow(r, hi)) * BSS + (32 * tb + r32) * 2) = (unsigned short)f2bf(st[r]);
        __syncthreads();
        const float cum_last = CUM[127];
#pragma unroll
        for (int i = 0; i < 2; ++i) { const int row = (tid >> 3) + 64 * i; const u32x4 v = rx[i]; const float te = EXP2(cum_last - DTV[row]);
            *(LAS u32x4*)(L + L_XD + lx + i * 64 * XSS) = (u32x4){pk2(bflo(v.x) * te, bfhi(v.x) * te), pk2(bflo(v.y) * te, bfhi(v.y) * te), pk2(bflo(v.z) * te, bfhi(v.z) * te), pk2(bflo(v.w) * te, bfhi(v.w) * te)}; }
        if (ck < 15) SSD_LOAD(ck + 1);
        const int t = 32 * tb + r32; const float cum_t = CUM[t];
        bf16x8 cf[8];
#pragma unroll
        for (int kn = 0; kn < 8; ++kn) cf[kn] = *(const LAS bf16x8*)(L + L_CS + t * BSS + (16 * kn + 8 * hi) * 2);
        SCHED_FENCE();
        f32x16 y = {};
        { bf16x8 sf[8];
#pragma unroll
          for (int kn = 0; kn < 8; ++kn) sf[kn] = *(const LAS bf16x8*)(L + L_SB + (32 * pb + r32) * BSS + (16 * kn + 8 * hi) * 2);
          SCHED_FENCE();
#pragma unroll
          for (int kn = 0; kn < 8; ++kn) y = mfma32(sf[kn], cf[kn], y);
          SCHED_FENCE(); }
        y *= EXP2(cum_t);
#define SSD_CB(xd_, sb_) do { xd_ = (f32x16){}; \
            _Pragma("unroll") for (int k4 = 0; k4 < 2; ++k4) { bf16x8 bfr[4]; \
                _Pragma("unroll") for (int kn = 0; kn < 4; ++kn) bfr[kn] = *(const LAS bf16x8*)(L + L_BS + (32 * (sb_) + r32) * 256 + 16 * ((2 * (4 * k4 + kn) + hi) ^ fs_row)); \
                SCHED_FENCE(); \
                _Pragma("unroll") for (int kn = 0; kn < 4; ++kn) xd_ = mfma32(bfr[kn], cf[4 * k4 + kn], xd_); \
                SCHED_FENCE(); } } while (0)
        f32x16 x; SSD_CB(x, 0);
#pragma unroll 1
        for (int sb = 0; sb <= tb; ++sb) {
            f32x16 xn; { const int sn = sb < tb ? sb + 1 : tb; SSD_CB(xn, sn); }
            const LAS unsigned char* xa = L + L_XS + (32 * sb + 4 * hi + trofs) * XSS + pb * 64 + trcol;
            const s16x4 t0 = tr_read(xa), t1 = tr_read(xa + 8 * XSS), t2 = tr_read(xa + 16 * XSS), t3 = tr_read(xa + 24 * XSS);
            { f32x4 ev[4];
#pragma unroll
              for (int g4 = 0; g4 < 4; ++g4) ev[g4] = *(const LAS f32x4*)(DTV + 32 * sb + 8 * g4 + 4 * hi);
              if (sb == tb) {
#pragma unroll
                for (int r = 0; r < 16; ++r) { const float wv = x[r] * EXP2(cum_t - ev[r >> 2][r & 3]); x[r] = (crow(r, hi) <= r32) ? wv : 0.f; }
              } else {
#pragma unroll
                for (int r = 0; r < 16; ++r) x[r] *= EXP2(cum_t - ev[r >> 2][r & 3]);
              } }
            const bf16x8 wf0 = pack8(x[0], x[1], x[2], x[3], x[4], x[5], x[6], x[7]), wf1 = pack8(x[8], x[9], x[10], x[11], x[12], x[13], x[14], x[15]);
            y = mfma32(cat4(t0, t1), wf0, y); y = mfma32(cat4(t2, t3), wf1, y);
            x = xn;
        }
        {
#pragma unroll
            for (int g4 = 0; g4 < 4; ++g4) { const int p0 = 32 * pb + 8 * g4 + 4 * hi; const u32x2 xv = *(const LAS u32x2*)(L + L_XS + t * XSS + p0 * 2);
                u32x2 o; o.x = pk2(y[4 * g4] + d_h * bflo(xv.x), y[4 * g4 + 1] + d_h * bfhi(xv.x)); o.y = pk2(y[4 * g4 + 2] + d_h * bflo(xv.y), y[4 * g4 + 3] + d_h * bfhi(xv.y));
                *(LAS u32x2*)(L + L_YT + t * XSS + p0 * 2) = o; }
        }
        asm volatile("s_waitcnt lgkmcnt(0)\n\ts_barrier" ::: "memory");
        const bf16* zb_ = zbase + (size_t)(128 * ck) * 2048; const u32x4 zc0 = *(const u32x4*)(zb_ + zo), zc1 = *(const u32x4*)(zb_ + (size_t)64 * 2048 + zo);
        st *= EXP2(cum_last);
        { const LAS unsigned char* xa = L + L_XD + (8 * hi + trofs) * XSS + pb * 64 + trcol;
          const int bch = 4 * tb + 2 * ((lane >> 4) & 1) + ((lane & 3) >> 1), bsub = 8 * (lane & 1);
          const LAS unsigned char* ba_lo = L + L_BS + (8 * hi + trofs) * 256 + 16 * (bch ^ f_lo) + bsub; const LAS unsigned char* ba_hi = L + L_BS + (8 * hi + trofs + 4) * 256 + 16 * (bch ^ f_hi) + bsub;
#pragma unroll
          for (int k4 = 0; k4 < 2; ++k4) { s16x4 ta[4], tb2[4], tc[4], td[4];
#pragma unroll
              for (int j = 0; j < 4; ++j) { const int ks = 4 * k4 + j; ta[j] = tr_read(xa + (16 * ks) * XSS); tb2[j] = tr_read(xa + (16 * ks + 4) * XSS); tc[j] = tr_read(ba_lo + (16 * ks) * 256); td[j] = tr_read(ba_hi + (16 * ks) * 256); }
              SCHED_FENCE();
#pragma unroll
              for (int j = 0; j < 4; ++j) st = mfma32(cat4(ta[j], tb2[j]), cat4(tc[j], td[j]), st);
              SCHED_FENCE(); } }
#pragma unroll
        for (int i = 0; i < 2; ++i) { const int row = (tid >> 3) + 64 * i; const u32x4 yv = *(const LAS u32x4*)(L + L_YT + lx + i * 64 * XSS); const size_t ga = (row0 + row) * 2048 + hd * 64 + (tid & 7) * 8; const u32x4 zv = i ? zc1 : zc0;
            const float o[8] = {bflo(yv.x) * bflo(zv.x), bfhi(yv.x) * bfhi(zv.x), bflo(yv.y) * bflo(zv.y), bfhi(yv.y) * bfhi(zv.y), bflo(yv.z) * bflo(zv.z), bfhi(yv.z) * bfhi(zv.z), bflo(yv.w) * bflo(zv.w), bfhi(yv.w) * bfhi(zv.w)};
            store_bf<8>(YZ + ga, o);
            { float ss = 0.f;
#pragma unroll
              for (int e8 = 0; e8 < 8; ++e8) ss += o[e8] * o[e8];
              ss += dpp_mov<0xB1>(ss); ss += dpp_mov<0x4E>(ss); ss += dpp_mov<0x141>(ss);
              if ((tid & 7) == 0) atomicAdd((float*)(ws + WS_GS) + (row0 + row) * 4 + g, ss); } }
        asm volatile("; SSD_CHUNK_END");
    }
    { unsigned so_off = (unsigned)((32 * pb + 4 * hi) * 128 + 32 * tb + r32); asm volatile("" : "+v"(so_off));
      float* so = p.out + O_SSMP + ((size_t)(b * 32 + hd) * 64) * 128 + so_off;
#pragma unroll
      for (int r = 0; r < 16; ++r) so[((r & 3) + 8 * (r >> 2)) * 128] = st[r]; }
    __syncthreads();
}
__device__ __forceinline__ void ssd_sample_unit(const Params& p, const Ctx& c, int b, int hd, const f32x4 (&sin)[4]) {
    unsigned char* ws = p.ws;
    const bf16* XB = (const bf16*)(ws + WS_XBCC); const bf16* ZS = (const bf16*)(ws + WS_ZS); const float* DT = (const float*)(ws + WS_DT); bf16* YZ = (bf16*)(ws + WS_YZ);
    const int tid = c.tid, pp = tid >> 3, n0 = (tid & 7) * 16, g = hd >> 3;
    const float a_h = -__expf(p.in[IN_OALOG][hd]), d_h = p.in[IN_OD][hd];
    float st[16];
#pragma unroll
    for (int i = 0; i < 4; ++i) { const f32x4 v = sin[i]; st[4 * i] = v.x; st[4 * i + 1] = v.y; st[4 * i + 2] = v.z; st[4 * i + 3] = v.w; }
#pragma unroll
    for (int t = 0; t < 4; ++t) { const size_t row = (size_t)MP + 4 * b + t; const float dt = DT[row * 32 + hd], dA = __expf(dt * a_h);
        const float xv = bf2f(XB[row * 3072 + hd * 64 + pp]);
        const u32x4 b0 = *(const u32x4*)(XB + row * 3072 + 2048 + g * 128 + n0), b1 = *(const u32x4*)(XB + row * 3072 + 2048 + g * 128 + n0 + 8);
        const u32x4 c0 = *(const u32x4*)(XB + row * 3072 + 2560 + g * 128 + n0), c1 = *(const u32x4*)(XB + row * 3072 + 2560 + g * 128 + n0 + 8);
        const float bv[16] = {bflo(b0.x), bfhi(b0.x), bflo(b0.y), bfhi(b0.y), bflo(b0.z), bfhi(b0.z), bflo(b0.w), bfhi(b0.w), bflo(b1.x), bfhi(b1.x), bflo(b1.y), bfhi(b1.y), bflo(b1.z), bfhi(b1.z), bflo(b1.w), bfhi(b1.w)};
        const float cv[16] = {bflo(c0.x), bfhi(c0.x), bflo(c0.y), bfhi(c0.y), bflo(c0.z), bfhi(c0.z), bflo(c0.w), bfhi(c0.w), bflo(c1.x), bfhi(c1.x), bflo(c1.y), bfhi(c1.y), bflo(c1.z), bfhi(c1.z), bflo(c1.w), bfhi(c1.w)};
        const float xdt = xv * dt; float y = 0.f;
#pragma unroll
        for (int i = 0; i < 16; ++i) { st[i] = fmaf(st[i], dA, xdt * bv[i]); y = fmaf(st[i], cv[i], y); }
        y += __shfl_xor(y, 1); y += __shfl_xor(y, 2); y += __shfl_xor(y, 4);
        if ((tid & 7) == 0) { const float z = bf2f(ZS[row * 2048 + hd * 64 + pp]); YZ[row * 2048 + hd * 64 + pp] = (bf16)f2bf((y + d_h * xv) * z); }
    }
    float* so = p.out + O_SSMS + (((size_t)b * 32 + hd) * 64 + pp) * 128 + n0;
#pragma unroll
    for (int i = 0; i < 4; ++i) __builtin_nontemporal_store((f32x4){st[4 * i], st[4 * i + 1], st[4 * i + 2], st[4 * i + 3]}, (f32x4*)(so + 4 * i));
}
__device__ __forceinline__ void phase_ssd(const Params& p, const Ctx& c) {
#ifndef REPSUB
#define REPSUB 0
#endif
#pragma unroll 1
    for (int rep = 0; rep < 1 + (REPSUB & 1); ++rep)
    { const int vcu = (c.G % 8 == 0) ? (c.cu & 7) * (c.G >> 3) + (c.cu >> 3) : c.cu;
      for (int u = vcu; u < 256; u += c.G) ssd_prompt_unit(p, c, u >> 5, u & 31); }
#pragma unroll 1
    for (int rep = 0; rep < 1 + ((REPSUB >> 1) & 1); ++rep)
    {
        const int tid = c.tid; const float* sbase = p.in[IN_SSM] + (size_t)(tid >> 3) * 128 + (tid & 7) * 16;
        f32x4 nx[4];
        if (c.cu < 1024) {
#pragma unroll
            for (int i = 0; i < 4; ++i) nx[i] = ldnt4(sbase + (size_t)c.cu * 64 * 128 + 4 * i); }
#pragma unroll 1
        for (int u = c.cu; u < 1024; u += c.G) {
            f32x4 cur[4];
#pragma unroll
            for (int i = 0; i < 4; ++i) cur[i] = nx[i];
            if (u + c.G < 1024) {
#pragma unroll
                for (int i = 0; i < 4; ++i) nx[i] = ldnt4(sbase + (size_t)(u + c.G) * 64 * 128 + 4 * i); }
            ssd_sample_unit(p, c, u >> 5, u & 31, cur);
        }
    }
}
__device__ __forceinline__ void phase_gnorm(const Params& p, const Ctx& c) {
    unsigned char* ws = p.ws; const bf16* YZ = (const bf16*)(ws + WS_YZ); bf16* YN = (bf16*)(ws + WS_YN); const float* nw = p.in[IN_ONORM];
    for (int r = c.gw; r < MT; r += c.NGW) {
#pragma unroll
        for (int j = 0; j < 4; ++j) { const int e0 = 8 * (c.lane + 64 * j); const u32x4 v = *(const u32x4*)(YZ + (size_t)r * 2048 + e0);
            const float x[8] = {bflo(v.x), bfhi(v.x), bflo(v.y), bfhi(v.y), bflo(v.z), bfhi(v.z), bflo(v.w), bfhi(v.w)};
            float s = 0.f;
#pragma unroll
            for (int e = 0; e < 8; ++e) s += x[e] * x[e];
            const float rr = rsqrtf(wave_sum(s) * (1.f / 512.f) + EPS); const f32x4 w0 = *(const f32x4*)(nw + e0), w1 = *(const f32x4*)(nw + e0 + 4);
            const float o[8] = {x[0] * rr * w0.x, x[1] * rr * w0.y, x[2] * rr * w0.z, x[3] * rr * w0.w, x[4] * rr * w1.x, x[5] * rr * w1.y, x[6] * rr * w1.z, x[7] * rr * w1.w};
            store_bf<8>(YN + (size_t)r * 2048 + e0, o); }
    }
}
constexpr int NPHASE = 22;
template <class F> __device__ __forceinline__ void run_gemm(const Ctx& c, const bf16* A, const bf16* Bt, int M, int N, int K, int cu_eff, const F& f) {
    pg8::Gemm g{A, Bt, M, N, K}; pg8::StaticOrder S; S.init(M, N, c.G, cu_eff);
    Epi8<F> E{f};
    pg8::gemm_phase<Epi8<F>, pg8::StaticOrder, true, true>((PG8_LAS unsigned char*)c.lds, g, S, E, c.tid);
}
__global__ void __launch_bounds__(512, 2) mega_fwd(Params p) {
    extern __shared__ __attribute__((aligned(16))) unsigned char lds_raw[];
    LAS unsigned char* const lds0 = (LAS unsigned char*)lds_raw;
    const int wave0 = __builtin_amdgcn_readfirstlane((int)threadIdx.x >> 6);
#define MKCTX() Ctx c; { int l_; asm volatile("v_mbcnt_lo_u32_b32 %0, -1, 0\n\tv_mbcnt_hi_u32_b32 %0, -1, %0" : "=v"(l_)); c.lds = lds0; c.lane = l_; c.wave = wave0; c.tid = wave0 * 64 + l_; \
        c.G = gridDim.x; c.cu = blockIdx.x; c.gw = c.cu * 8 + c.wave; c.NGW = c.G * 8; }
    unsigned char* ws = p.ws;
    volatile LAS unsigned* MISC = (volatile LAS unsigned*)(lds0 + MISC_OFF);
    { MKCTX(); for (int u = c.tid; u < (LDS_BYTES - RING_BYTES) / 4; u += 512) ((LAS unsigned*)(lds0 + RING_BYTES))[u] = 0u; }
    __syncthreads();
    const int lo = p.ph_lo, hi = p.ph_hi;
    const bool multi = (hi - lo) > 1;
    XcdBarrier bar; bar.bar = (unsigned*)(ws + WS_CTL) + CW_BAR; bar.x = 0; bar.st = nullptr;
    if (multi) { MKCTX(); bar = xcd_barrier_post((unsigned*)(ws + WS_CTL) + CW_BAR, MISC + 8, c.tid); }
#ifndef PHMASK
#define PHMASK 0x3fffff
#endif
#define IN(k) ((((PHMASK) >> (k)) & 1) && lo <= (k) && (k) < hi)
#ifndef REPMASK
#define REPMASK 0
#endif
#define NREP(k) (1 + (((REPMASK) >> (k)) & 1))
#define REPBAR(r) do { if (r) { MKCTX(); xcd_barrier(bar, c.tid); } } while (0)
#define SEAM(k) do { if (IN(k) && IN((k) + 1)) { MKCTX(); xcd_barrier(bar, c.tid); } } while (0)
    bf16* H = (bf16*)(ws + WS_H); bf16* YB = (bf16*)(ws + WS_YB); bf16* YCAT = (bf16*)(ws + WS_YCAT);

    if (IN(0)) _Pragma("unroll") for (int rep_ = 0; rep_ < NREP(0); ++rep_) { REPBAR(rep_); MKCTX(); phase_prep(p, c); } SEAM(0);
    if (IN(1)) _Pragma("unroll") for (int rep_ = 0; rep_ < NREP(1); ++rep_) { REPBAR(rep_); MKCTX();
        FGemm1 f{(bf16*)(ws + WS_GLU), (bf16*)(ws + WS_GATE), (bf16*)(ws + WS_CQ), (bf16*)(ws + WS_KVRAW)};
        run_gemm(c, H, (const bf16*)(ws + WS_WEIN), MP, 2560, 1024, c.cu, f);
#pragma unroll 1
        for (int i = 0; i < 2; ++i) { FMemKV fm{p.out + O_MK + (size_t)i * 2048 * 1024, p.out + O_MV + (size_t)i * 2048 * 1024, (bf16*)(ws + WS_MKV) + (size_t)(2 * i) * 2048 * 1024, (bf16*)(ws + WS_MKV) + (size_t)(2 * i + 1) * 2048 * 1024};
            run_gemm(c, (const bf16*)(ws + WS_MN) + (size_t)i * 2048 * 1024, (const bf16*)(ws + WS_WMKV) + (size_t)i * 2048 * 1024, 2048, 2048, 1024, (c.cu + c.G - c.G / 2 - i * (c.G / 4)) % c.G, fm); }
        skinny_sample(c, H, 1024, (const bf16*)(ws + WS_WEIN), 1024, 1024, 2560, f, 0);
    } SEAM(1);
    if (IN(2)) _Pragma("unroll") for (int rep_ = 0; rep_ < NREP(2); ++rep_) { REPBAR(rep_); MKCTX(); phase_conv(p, c); } SEAM(2);
    if (IN(3)) _Pragma("unroll") for (int rep_ = 0; rep_ < NREP(3); ++rep_) { REPBAR(rep_); MKCTX();
        FQ f{(bf16*)(ws + WS_QP), (const float*)(ws + WS_ROPE)};
        run_gemm(c, (const bf16*)(ws + WS_CQN), (const bf16*)(ws + WS_WQ), MP, 1280, 256, c.cu, f);
        skinny_sample(c, (const bf16*)(ws + WS_CQN), 256, (const bf16*)(ws + WS_WQ), 256, 256, 1280, f, 64);
    } SEAM(3);
    if (IN(4)) _Pragma("unroll") for (int rep_ = 0; rep_ < NREP(4); ++rep_) { REPBAR(rep_); MKCTX(); phase_mla(p, c); } SEAM(4);
    if (IN(5)) _Pragma("unroll") for (int rep_ = 0; rep_ < NREP(5); ++rep_) { REPBAR(rep_); MKCTX(); for (int b = c.cu; b < NBS; b += c.G) mla_combine_unit(p, c, b); } SEAM(5);
    if (IN(6)) _Pragma("unroll") for (int rep_ = 0; rep_ < NREP(6); ++rep_) { REPBAR(rep_); MKCTX();
        FPlain f{YB, 1024};
        run_gemm(c, YCAT, (const bf16*)(ws + WS_WEOUT), MP, 1024, 1024, c.cu, f);
        skinny_sample(c, YCAT, 1024, (const bf16*)(ws + WS_WEOUT), 1024, 1024, 1024, f, 0);
    } SEAM(6);
    if (IN(7)) _Pragma("unroll") for (int rep_ = 0; rep_ < NREP(7); ++rep_) { REPBAR(rep_); MKCTX(); phase_resid<0>(p, c, p.in[IN_NQM], p.in[IN_NPX]); } SEAM(7);
#define CROSS_PHASES(layer, pb) do { \
        if (IN(pb)) _Pragma("unroll") for (int rep_ = 0; rep_ < NREP(pb); ++rep_) { REPBAR(rep_); MKCTX(); FQG f{(bf16*)(ws + WS_XQ), (bf16*)(ws + WS_XG)}; \
            run_gemm(c, H, (const bf16*)(ws + WS_WQG) + (size_t)(layer) * 2048 * 1024, MP, 2048, 1024, c.cu, f); \
            skinny_sample(c, H, 1024, (const bf16*)(ws + WS_WQG) + (size_t)(layer) * 2048 * 1024, 1024, 1024, 2048, f, 0); } SEAM(pb); \
        if (IN((pb) + 1)) _Pragma("unroll") for (int rep_ = 0; rep_ < NREP((pb) + 1); ++rep_) { REPBAR(rep_); MKCTX(); phase_xattn(p, c, layer); } SEAM((pb) + 1); \
        if (IN((pb) + 2)) _Pragma("unroll") for (int rep_ = 0; rep_ < NREP((pb) + 2); ++rep_) { REPBAR(rep_); MKCTX(); FPlain f{YB, 1024}; \
            run_gemm(c, (const bf16*)(ws + WS_XO), (const bf16*)(ws + WS_WXO) + (size_t)(layer) * 1024 * 1024, MP, 1024, 1024, c.cu, f); \
            skinny_sample(c, (const bf16*)(ws + WS_XO), 1024, (const bf16*)(ws + WS_WXO) + (size_t)(layer) * 1024 * 1024, 1024, 1024, 1024, f, 0); } SEAM((pb) + 2); \
        if (IN((pb) + 3)) _Pragma("unroll") for (int rep_ = 0; rep_ < NREP((pb) + 3); ++rep_) { REPBAR(rep_); MKCTX(); if ((layer) == 0) phase_resid<1>(p, c, p.in[IN_NQX], p.in[IN_NPM] + DM); else phase_resid<2>(p, c, p.in[IN_NQX] + DM, nullptr); } SEAM((pb) + 3); \
    } while (0)
    CROSS_PHASES(0, 8);
    if (IN(12)) _Pragma("unroll") for (int rep_ = 0; rep_ < NREP(12); ++rep_) { REPBAR(rep_); MKCTX();
        FOIn f{(bf16*)(ws + WS_ZS), (bf16*)(ws + WS_XBC)};
        run_gemm(c, H, (const bf16*)(ws + WS_WOIN), MP, 5120, 1024, c.cu, f);
        skinny_sample(c, H, 1024, (const bf16*)(ws + WS_WOIN), 1024, 1024, 5120, f, 0);
        FDt fd{(float*)(ws + WS_DT), p.in[IN_ODTB]};
        for (int u = (c.cu + c.G - 160 % c.G) % c.G; u < MT / 64; u += c.G) { const bf16* Bu = (const bf16*)(ws + WS_WDT); asm volatile("" : "+s"(Bu)); skinny_unit(c, H, 1024, Bu, 1024, 1024, 64 * u, 0, 64 * u + 32, 0, fd); }
    } SEAM(12);
    if (IN(13)) _Pragma("unroll") for (int rep_ = 0; rep_ < NREP(13); ++rep_) { REPBAR(rep_); MKCTX(); phase_conv4(p, c); } SEAM(13);
    if (IN(14)) _Pragma("unroll") for (int rep_ = 0; rep_ < NREP(14); ++rep_) { REPBAR(rep_); MKCTX(); phase_ssd(p, c); } SEAM(14);
    if (IN(16)) _Pragma("unroll") for (int rep_ = 0; rep_ < NREP(16); ++rep_) { REPBAR(rep_); MKCTX();
        { pg8::Gemm g{(const bf16*)(ws + WS_YZ), (const bf16*)(ws + WS_WOOUT), MP, 1024, 2048}; pg8::StaticOrder S; S.init(MP, 1024, c.G, c.cu);
          EpiGN E{YB, (const float*)(ws + WS_GS), (PG8_LAS unsigned char*)c.lds, c.G < 256 ? 1 : 0};
          pg8::gemm_phase<EpiGN, pg8::StaticOrder, true, true>((PG8_LAS unsigned char*)c.lds, g, S, E, c.tid); }
        FPlain f{YB, 1024};
        skinny_sample<true>(c, (const bf16*)(ws + WS_YZ), 2048, (const bf16*)(ws + WS_WOOUT), 2048, 2048, 1024, f, 0);
    } SEAM(16);
    if (IN(17)) _Pragma("unroll") for (int rep_ = 0; rep_ < NREP(17); ++rep_) { REPBAR(rep_); MKCTX(); phase_resid<1>(p, c, p.in[IN_NQM] + DM, p.in[IN_NPX] + DM); } SEAM(17);
    CROSS_PHASES(1, 18);
#undef IN
#undef SEAM
}

extern "C" void kernel_launch(void* const* d_in, const int* in_sizes, int n_in, void* d_out, int out_size, void* d_ws, size_t ws_size, hipStream_t stream) {
    static int grid = 0;
    if (grid == 0) {
        if (n_in != 39 || (size_t)out_size != O_END || ws_size < WS_END) { fprintf(stderr, "kernel_launch: unexpected shapes: n_in %d out %d ws %zu (need %zu)\n", n_in, out_size, ws_size, (size_t)WS_END); grid = -1; return; }
        int dev = 0, cus = 0, per_cu = 0;
        if (hipGetDevice(&dev) != hipSuccess || hipDeviceGetAttribute(&cus, hipDeviceAttributeMultiprocessorCount, dev) != hipSuccess) { grid = -1; return; }
        if (hipFuncSetAttribute((const void*)mega_fwd, hipFuncAttributeMaxDynamicSharedMemorySize, LDS_BYTES) != hipSuccess) { fprintf(stderr, "kernel_launch: hipFuncSetAttribute failed\n"); grid = -1; return; }
        if (hipOccupancyMaxActiveBlocksPerMultiprocessor(&per_cu, (const void*)mega_fwd, 512, LDS_BYTES) != hipSuccess || per_cu < 1) { fprintf(stderr, "kernel_launch: occupancy query says %d blocks per CU\n", per_cu); per_cu = 1; }
        (void)hipGetLastError();
        grid = cus;
    }
    if (grid < 0) return;
    (void)hipMemsetAsync((char*)d_ws + WS_CTL + (size_t)CW_BAR * 4, 0, (size_t)XCD_BAR_WORDS * 4, stream);
    Params a{};
    for (int i = 0; i < 39; ++i) a.in[i] = (const float*)d_in[i];
    a.out = (float*)d_out; a.ws = (unsigned char*)d_ws;
#ifndef MK_ONE_LAUNCH
#define MK_ONE_LAUNCH 1
#endif
    if (MK_ONE_LAUNCH) { a.ph_lo = 0; a.ph_hi = NPHASE; hipLaunchKernelGGL(mega_fwd, dim3(grid), dim3(512), LDS_BYTES, stream, a); }
    else for (int ph = 0; ph < NPHASE; ++ph) { a.ph_lo = ph; a.ph_hi = ph + 1; hipLaunchKernelGGL(mega_fwd, dim3(grid), dim3(512), LDS_BYTES, stream, a); }
}
```

```cpp
#include <hip/hip_runtime.h>
#include <cstdio>
#include <cstdint>
namespace pg8 {
#define PG8_LAS __attribute__((address_space(3)))
typedef unsigned short bf16_t;
typedef short bf16x8 __attribute__((ext_vector_type(8)));
typedef float f32x4 __attribute__((ext_vector_type(4)));
typedef unsigned u32x4 __attribute__((ext_vector_type(4)));
constexpr int BM = 256, BK = 64, HALF = 128, HTB = HALF * BK * 2  , STAGE_BYTES = 8 * HTB, NXCD = 8, WGM = 8;

__host__ __device__ __forceinline__ int lds_byte(int r, int c) { const int st = (r >> 4) * 2 + (c >> 5), rr = r & 15, cc = c & 31, ob = rr * 64 + cc * 2; return st * 1024 + (ob ^ (((ob >> 9) & 1) << 5)); }
__host__ __device__ __forceinline__ void stage_rc(int b, int& R, int& C) { const int st = b / 1024, sb = b % 1024, swz = sb ^ (((sb >> 9) & 1) << 5); R = (st >> 1) * 16 + swz / 64; C = (st & 1) * 32 + (swz % 64) / 2; }
__host__ __device__ __forceinline__ int perm32(int rho) { const int n = rho >> 4, i = rho & 15; return 8 * (i >> 2) + 4 * n + (i & 3); }

struct Unit { int pm, pn; };
struct Gemm { const bf16_t* A; const bf16_t* Bt; int M, N, K; };

struct StaticOrder {
    int nM, nN, nwg, G, c;
    __host__ __device__ void init(int M, int N, int G_, int c_) { nM = M / BM; nN = N / BM; nwg = nM * nN; G = G_; c = c_; }
    __host__ __device__ bool next(int i, Unit& u) const {
        const long L = (long)i * G + c; if (L >= nwg) return false;
        int wgid = (int)L; { const int q = nwg / NXCD, r = nwg % NXCD, xcd = wgid % NXCD, off = wgid / NXCD; wgid = (xcd < r ? xcd * (q + 1) : r * (q + 1) + (xcd - r) * q) + off; }
        const int nig = WGM * nN, gid = wgid / nig, fm = gid * WGM, gsz = (nM - fm) < WGM ? (nM - fm) : WGM;
        u.pm = fm + ((wgid % nig) % gsz); u.pn = (wgid % nig) / gsz; return true;
    }
    __device__ __forceinline__ void a_ready(const Unit&) const {}
    __device__ __forceinline__ void done(const Unit&) const {}
};
template <class Epi, class Sched, bool ALIGN_EPI = false, bool SP2 = false>
__device__ __forceinline__ void gemm_phase(PG8_LAS unsigned char* lds, const Gemm g, const Sched& S, const Epi& E, const int tid_in) {
    const int tid = tid_in, wid = __builtin_amdgcn_readfirstlane(tid >> 6), lane = tid & 63, wr = wid >> 2, wc = wid & 3, fr = lane & 15, fq = lane >> 4;
    const int K = g.K, nt = K / BK;
    unsigned voffA[2], voffB[2];
#pragma unroll
    for (int i = 0; i < 2; ++i) { int R, C; stage_rc(tid * 16 + i * 8192, R, C); const int Rb = Epi::PERM ? ((R & ~31) + perm32(R & 31)) : R;
        voffA[i] = (unsigned)(R * K + C) * 2u; voffB[i] = (unsigned)(Rb * K + C) * 2u; }
    const size_t kstep = (size_t)(BK * 2);
    const size_t hstep = (size_t)HALF * K * 2;
    const size_t tstep = 2 * hstep;
    const unsigned ldsw = (unsigned)wid * 1024u;
    const int aoff = lds_byte(wr * 64 + fr, fq * 8), boff = lds_byte(wc * 32 + fr, fq * 8);
#define PG8_SA(b, h) (((b) * 2 + (h)) * HTB)
#define PG8_SB(b, h) ((4 + (b) * 2 + (h)) * HTB)
#define PG8_STAGE(bufoff, gbase, voff) do { _Pragma("unroll") for (int _i = 0; _i < 2; ++_i) \
        __builtin_amdgcn_global_load_lds((const unsigned*)((const char*)(gbase) + (voff)[_i]), (PG8_LAS unsigned*)(lds + (bufoff) + ldsw + _i * 8192), 16, 0, 0); } while (0)
#define PG8_LDA(dst, b, h) do { _Pragma("unroll") for (int m = 0; m < 4; ++m) _Pragma("unroll") for (int k = 0; k < 2; ++k) dst[m][k] = *(const PG8_LAS bf16x8*)(lds + PG8_SA(b, h) + aoff + m * 2048 + k * 1024); } while (0)
#define PG8_LDB(dst, b, h) do { _Pragma("unroll") for (int n = 0; n < 2; ++n) _Pragma("unroll") for (int k = 0; k < 2; ++k) dst[n][k] = *(const PG8_LAS bf16x8*)(lds + PG8_SB(b, h) + boff + n * 2048 + k * 1024); } while (0)
#define PG8_MMA(ai, bj, At, Bt) do { __builtin_amdgcn_s_setprio(1); _Pragma("unroll") for (int m = 0; m < 4; ++m) _Pragma("unroll") for (int n = 0; n < 2; ++n) _Pragma("unroll") for (int k = 0; k < 2; ++k) \
        acc[ai][bj][m][n] = __builtin_amdgcn_mfma_f32_16x16x32_bf16(Bt[n][k], At[m][k], acc[ai][bj][m][n], 0, 0, 0); __builtin_amdgcn_s_setprio(0); } while (0)
#define PG8_WAIT_V(n) asm volatile("s_waitcnt vmcnt(" #n ")" ::: "memory")
#define PG8_WAIT_L(n) asm volatile("s_waitcnt lgkmcnt(" #n ")" ::: "memory")
#define PG8_BAR __builtin_amdgcn_s_barrier()
#define PG8_SCHED __builtin_amdgcn_sched_barrier(0)
    Unit cur, nxt; int ui = 0;
    if (!S.next(0, cur)) return;
    f32x4 acc[2][2][4][2];
#pragma unroll
    for (int a = 0; a < 2; ++a)
#pragma unroll
        for (int b = 0; b < 2; ++b)
#pragma unroll
            for (int m = 0; m < 4; ++m)
#pragma unroll
                for (int n = 0; n < 2; ++n) acc[a][b][m][n] = (f32x4){0.f, 0.f, 0.f, 0.f};
    bf16x8 At[4][2], B0[2][2], B1[2][2];
    const char* cA = (const char*)g.A + (size_t)cur.pm * tstep; const char* cB = (const char*)g.Bt + (size_t)cur.pn * tstep;
    S.a_ready(cur);
    if constexpr (Epi::KGROUP) E.unit_begin(cur, lds, wr, fr);
    if constexpr (SP2) {
        PG8_STAGE(PG8_SB(0, 0), cB, voffB); PG8_STAGE(PG8_SB(0, 1), cB + hstep, voffB); PG8_STAGE(PG8_SA(0, 0), cA, voffA); PG8_STAGE(PG8_SA(0, 1), cA + hstep, voffA);
        if (wr == 1) PG8_BAR;
        PG8_WAIT_V(2); PG8_BAR;
        PG8_STAGE(PG8_SB(1, 0), cB + kstep, voffB); PG8_STAGE(PG8_SA(1, 0), cA + kstep, voffA); PG8_STAGE(PG8_SB(1, 1), cB + hstep + kstep, voffB);
        PG8_WAIT_V(6); PG8_BAR;
    } else {
        PG8_STAGE(PG8_SB(0, 0), cB, voffB); PG8_STAGE(PG8_SA(0, 0), cA, voffA); PG8_STAGE(PG8_SB(0, 1), cB + hstep, voffB); PG8_STAGE(PG8_SA(0, 1), cA + hstep, voffA);
        if (wr == 1) PG8_BAR;
        PG8_WAIT_V(4); PG8_BAR;
        PG8_STAGE(PG8_SB(1, 0), cB + kstep, voffB); PG8_STAGE(PG8_SA(1, 0), cA + kstep, voffA); PG8_STAGE(PG8_SB(1, 1), cB + hstep + kstep, voffB);
        PG8_WAIT_V(6); PG8_BAR;
    }
    for (;;) {
        const bool has_next = S.next(ui + 1, nxt);
        const char* nA = has_next ? (const char*)g.A + (size_t)nxt.pm * tstep : cA; const char* nB = has_next ? (const char*)g.Bt + (size_t)nxt.pn * tstep : cB;
        for (int t = 0; t < nt; t += 2) {
            if constexpr (Epi::KGROUP) { if ((t & 7) == 0) E.kgroup(acc, lds, t >> 3, wr, fr); }
            const bool last = (t == nt - 2);
            const char* a1 = cA + (size_t)(t + 1) * kstep;
            const char* a2 = last ? nA : cA + (size_t)(t + 2) * kstep; const char* b2 = last ? nB : cB + (size_t)(t + 2) * kstep;
            const char* a3 = a2 + kstep; const char* b3 = b2 + kstep;
            if (last && has_next) S.a_ready(nxt);
            if constexpr (SP2) {
            PG8_LDB(B0, 0, 0); PG8_LDB(B1, 0, 1); PG8_SCHED; PG8_LDA(At, 0, 0); PG8_STAGE(PG8_SA(1, 1), a1 + hstep, voffA);
            PG8_WAIT_V(8); PG8_WAIT_L(0); PG8_BAR; PG8_MMA(0, 0, At, B0); PG8_MMA(0, 1, At, B1); PG8_BAR; PG8_SCHED;
            PG8_LDA(At, 0, 1); PG8_STAGE(PG8_SB(0, 0), b2, voffB); PG8_STAGE(PG8_SB(0, 1), b2 + hstep, voffB); PG8_STAGE(PG8_SA(0, 0), a2, voffA);
            PG8_WAIT_V(8); PG8_WAIT_L(0); PG8_BAR; PG8_MMA(1, 0, At, B0); PG8_MMA(1, 1, At, B1); PG8_BAR; PG8_SCHED;
            PG8_LDB(B0, 1, 0); PG8_LDB(B1, 1, 1); PG8_SCHED; PG8_LDA(At, 1, 0); PG8_STAGE(PG8_SA(0, 1), a2 + hstep, voffA);
            PG8_WAIT_V(8); PG8_WAIT_L(0); PG8_BAR; PG8_MMA(0, 0, At, B0); PG8_MMA(0, 1, At, B1); PG8_BAR; PG8_SCHED;
            PG8_LDA(At, 1, 1); PG8_STAGE(PG8_SB(1, 0), b3, voffB); PG8_STAGE(PG8_SB(1, 1), b3 + hstep, voffB); PG8_STAGE(PG8_SA(1, 0), a3, voffA);
            PG8_WAIT_V(8); PG8_WAIT_L(0); PG8_BAR; PG8_MMA(1, 0, At, B0); PG8_MMA(1, 1, At, B1); PG8_BAR; PG8_SCHED;
            } else {
            PG8_LDB(B0, 0, 0); PG8_SCHED; PG8_LDA(At, 0, 0); PG8_STAGE(PG8_SA(1, 1), a1 + hstep, voffA);
            PG8_WAIT_L(8); PG8_BAR; PG8_WAIT_L(0); PG8_MMA(0, 0, At, B0); PG8_BAR; PG8_SCHED;
            PG8_LDB(B1, 0, 1); PG8_STAGE(PG8_SB(0, 0), b2, voffB);
            PG8_BAR; PG8_WAIT_L(0); PG8_MMA(0, 1, At, B1); PG8_BAR;
            PG8_LDA(At, 0, 1); PG8_STAGE(PG8_SA(0, 0), a2, voffA);
            PG8_BAR; PG8_WAIT_L(0); PG8_MMA(1, 0, At, B0); PG8_BAR; PG8_SCHED;
            PG8_STAGE(PG8_SB(0, 1), b2 + hstep, voffB);
            PG8_WAIT_V(6); PG8_BAR; PG8_MMA(1, 1, At, B1); PG8_BAR;
            PG8_LDB(B0, 1, 0); PG8_SCHED; PG8_LDA(At, 1, 0); PG8_STAGE(PG8_SA(0, 1), a2 + hstep, voffA);
            PG8_WAIT_L(8); PG8_BAR; PG8_WAIT_L(0); PG8_MMA(0, 0, At, B0); PG8_BAR; PG8_SCHED;
            PG8_LDB(B1, 1, 1); PG8_STAGE(PG8_SB(1, 0), b3, voffB);
            PG8_BAR; PG8_WAIT_L(0); PG8_MMA(0, 1, At, B1); PG8_BAR;
            PG8_LDA(At, 1, 1); PG8_STAGE(PG8_SA(1, 0), a3, voffA);
            PG8_BAR; PG8_WAIT_L(0); PG8_MMA(1, 0, At, B0); PG8_BAR; PG8_SCHED;
            PG8_STAGE(PG8_SB(1, 1), b3 + hstep, voffB);
            PG8_WAIT_V(6); PG8_BAR; PG8_MMA(1, 1, At, B1); PG8_BAR;
            }
        }
        if constexpr (ALIGN_EPI) { if (wr == 0) PG8_BAR; }
        if constexpr (!Epi::AFTER_DRAIN) { E(acc, cur, wr, wc, fr, fq); S.done(cur); }
        if (!has_next) break;
#pragma unroll
        for (int a = 0; a < 2; ++a)
#pragma unroll
            for (int b = 0; b < 2; ++b)
#pragma unroll
                for (int m = 0; m < 4; ++m)
#pragma unroll
                    for (int n = 0; n < 2; ++n) acc[a][b][m][n] = (f32x4){0.f, 0.f, 0.f, 0.f};
        cur = nxt; cA = nA; cB = nB; ++ui;
        if constexpr (Epi::KGROUP) E.unit_begin(cur, lds, wr, fr);
        if constexpr (ALIGN_EPI) { if (wr == 1) PG8_BAR; }
    }
    PG8_WAIT_V(0);
    if constexpr (!ALIGN_EPI) { if (wr == 0) PG8_BAR; }
    PG8_BAR;
    if constexpr (Epi::AFTER_DRAIN) { E.fused(acc, cur, wr, wc, fr, fq, lds, wid, lane); S.done(cur); }
#undef PG8_SA
#undef PG8_SB
#undef PG8_STAGE
#undef PG8_LDA
#undef PG8_LDB
#undef PG8_MMA
#undef PG8_WAIT_V
#undef PG8_WAIT_L
#undef PG8_BAR
#undef PG8_SCHED
}
}
#define GAS __attribute__((address_space(1)))
#define LAS __attribute__((address_space(3)))
typedef unsigned short bf16;
typedef short bf16x8 __attribute__((ext_vector_type(8)));
typedef short s16x4 __attribute__((ext_vector_type(4)));
typedef float f32x4 __attribute__((ext_vector_type(4)));
typedef float f32x2 __attribute__((ext_vector_type(2)));
typedef float f32x16 __attribute__((ext_vector_type(16)));
typedef unsigned u32x4 __attribute__((ext_vector_type(4)));
typedef unsigned u32x2 __attribute__((ext_vector_type(2)));
typedef GAS unsigned gu32;
#define RLX_AGENT __ATOMIC_RELAXED, __HIP_MEMORY_SCOPE_AGENT
#define LDS_WAIT() asm volatile("s_waitcnt lgkmcnt(0)" ::: "memory")
__device__ __forceinline__ f32x4 ldnt4(const float* p) { return __builtin_nontemporal_load((const f32x4*)p); }
#define PRIO_HI() __builtin_amdgcn_s_setprio(1)
#define PRIO_LO() __builtin_amdgcn_s_setprio(0)
#define SCHED_FENCE() __builtin_amdgcn_sched_barrier(0)
#define VM_WAIT() asm volatile("s_waitcnt vmcnt(0)" ::: "memory")

typedef __bf16 bf16x2_t __attribute__((ext_vector_type(2)));
__device__ __forceinline__ unsigned pk2(float lo, float hi) { const f32x2 v = {lo, hi}; const bf16x2_t b = __builtin_convertvector(v, bf16x2_t); return __builtin_bit_cast(unsigned, b); }
__device__ __forceinline__ unsigned f2bf(float f) { return pk2(f, 0.f) & 0xffffu; }
__device__ __forceinline__ float bf2f(unsigned h) { return __builtin_bit_cast(float, h << 16); }
__device__ __forceinline__ float bflo(unsigned w) { return __builtin_bit_cast(float, w << 16); }
__device__ __forceinline__ float bfhi(unsigned w) { return __builtin_bit_cast(float, w & 0xffff0000u); }
template <int CTRL> __device__ __forceinline__ float dpp_mov(float v) { return __builtin_bit_cast(float, __builtin_amdgcn_update_dpp(0, __builtin_bit_cast(int, v), CTRL, 0xF, 0xF, false)); }
__device__ __forceinline__ float wave_sum(float v) {
    v += dpp_mov<0xB1>(v); v += dpp_mov<0x4E>(v); v += dpp_mov<0x124>(v); v += dpp_mov<0x128>(v);
    const int b = __builtin_bit_cast(int, v);
    const float s0 = __builtin_bit_cast(float, __builtin_amdgcn_readlane(b, 0)), s1 = __builtin_bit_cast(float, __builtin_amdgcn_readlane(b, 16));
    const float s2 = __builtin_bit_cast(float, __builtin_amdgcn_readlane(b, 32)), s3 = __builtin_bit_cast(float, __builtin_amdgcn_readlane(b, 48));
    return (s0 + s1) + (s2 + s3);
}
__device__ __forceinline__ float xhalf(float v) { const unsigned u = __builtin_bit_cast(unsigned, v); const auto r = __builtin_amdgcn_permlane32_swap(u, u, false, false);
    const int hi = (int)(__builtin_amdgcn_mbcnt_hi(~0u, __builtin_amdgcn_mbcnt_lo(~0u, 0u)) >> 5); return __builtin_bit_cast(float, hi ? r[0] : r[1]); }
__device__ __forceinline__ float sigmoidf_(float x) { return __builtin_amdgcn_rcpf(1.f + __expf(-x)); }
__device__ __forceinline__ float siluf_(float x) { return x * __builtin_amdgcn_rcpf(1.f + __expf(-x)); }
__device__ __forceinline__ float max3f(float a, float b, float c) { float r; asm("v_max3_f32 %0, %1, %2, %3" : "=v"(r) : "v"(a), "v"(b), "v"(c)); return r; }
__device__ __forceinline__ float max2f(float a, float b) { float r; asm("v_max_f32_e32 %0, %1, %2" : "=v"(r) : "v"(a), "v"(b)); return r; }
__device__ __forceinline__ int crow(int r, int hi) { return (r & 3) + 8 * (r >> 2) + 4 * hi; }
__device__ __forceinline__ f32x16 mfma32(bf16x8 a, bf16x8 b, f32x16 c) { return __builtin_amdgcn_mfma_f32_32x32x16_bf16(a, b, c, 0, 0, 0); }
typedef short v4i16_t __attribute__((ext_vector_type(4)));
__device__ __forceinline__ s16x4 tr_read(const LAS unsigned char* p) { return __builtin_bit_cast(s16x4, __builtin_amdgcn_ds_read_tr16_b64_v4i16((LAS v4i16_t*)p)); }
__device__ __forceinline__ bf16x8 cat4(s16x4 lo, s16x4 hi) { return (bf16x8){lo[0], lo[1], lo[2], lo[3], hi[0], hi[1], hi[2], hi[3]}; }
__device__ __forceinline__ bf16x8 pack8(float a0, float a1, float a2, float a3, float a4, float a5, float a6, float a7) {
    u32x4 w; w.x = pk2(a0, a1); w.y = pk2(a2, a3); w.z = pk2(a4, a5); w.w = pk2(a6, a7); return __builtin_bit_cast(bf16x8, w);
}

constexpr int DM = 1024, MP = 16384, MS = 128, MT = MP + MS, MR = 16640, TP = 2048, NBP = 8, NBS = 32, TS = 4;
constexpr float EPS = 1e-6f;
constexpr float LOG2E = 1.4426950408889634f;
constexpr float C_MLA = 0.10206207261596575f * LOG2E;
constexpr float C_X = 0.0625f * LOG2E;

constexpr size_t O_Y = 0, O_YS = O_Y + (size_t)MP * DM, O_CKVP = O_YS + (size_t)MS * DM, O_CKVS = O_CKVP + (size_t)MP * 128, O_KRP = O_CKVS + (size_t)MS * 128,
    O_KRS = O_KRP + (size_t)MP * 32, O_CAP = O_KRS + (size_t)MS * 32, O_CAS = O_CAP + (size_t)8 * 30 * 512, O_CCP = O_CAS + (size_t)32 * 30 * 512,
    O_CCS = O_CCP + (size_t)8 * 3 * 3072, O_SSMP = O_CCS + (size_t)32 * 3 * 3072, O_SSMS = O_SSMP + (size_t)8 * 32 * 64 * 128, O_MK = O_SSMS + (size_t)32 * 32 * 64 * 128,
    O_MV = O_MK + (size_t)2 * 2048 * 1024, O_END = O_MV + (size_t)2 * 2048 * 1024;

constexpr size_t al256(size_t x) { return (x + 255) & ~(size_t)255; }
constexpr size_t WS_CTL = 0, CTL_BYTES = 1u << 20;
constexpr size_t WS_WEIN = CTL_BYTES;
constexpr size_t WS_WMKV = WS_WEIN + (size_t)2560 * 1024 * 2;
constexpr size_t WS_WQ = WS_WMKV + (size_t)2 * 2048 * 1024 * 2;
constexpr size_t WS_WUVT = WS_WQ + (size_t)1280 * 256 * 2;
constexpr size_t WS_WEOUT = WS_WUVT + (size_t)8 * 64 * 128 * 2;
constexpr size_t WS_WQG = WS_WEOUT + (size_t)1024 * 1024 * 2;
constexpr size_t WS_WXO = WS_WQG + (size_t)2 * 2048 * 1024 * 2;
constexpr size_t WS_WOIN = WS_WXO + (size_t)2 * 1024 * 1024 * 2;
constexpr size_t WS_WDT = WS_WOIN + (size_t)5120 * 1024 * 2;
constexpr size_t WS_WOOUT = WS_WDT + (size_t)32 * 1024 * 2;
constexpr size_t WS_ROPE = WS_WOOUT + (size_t)1024 * 2048 * 2;
constexpr size_t WS_H = al256(WS_ROPE + (size_t)2052 * 32 * 4);
constexpr size_t WS_MN = WS_H + (size_t)MR * 1024 * 2;
constexpr size_t WS_GLU = WS_MN + (size_t)2 * 2048 * 1024 * 2;
constexpr size_t WS_GATE = WS_GLU + (size_t)MR * 512 * 2;
constexpr size_t WS_CQ = WS_GATE + (size_t)MR * 1024 * 2;
constexpr size_t WS_CQN = WS_CQ + (size_t)MR * 256 * 2;
constexpr size_t WS_KVRAW = WS_CQN + (size_t)MR * 256 * 2;
constexpr size_t WS_KP = WS_KVRAW + (size_t)MR * 256 * 2;
constexpr size_t WS_QP = WS_KP + (size_t)MR * 160 * 2;
constexpr size_t WS_YCAT = WS_QP + (size_t)MR * 1280 * 2;
constexpr size_t WS_YB = WS_YCAT + (size_t)MR * 1024 * 2;
constexpr size_t WS_XQ = WS_YB + (size_t)MR * 1024 * 2;
constexpr size_t WS_XG = WS_XQ + (size_t)MR * 1024 * 2;
constexpr size_t WS_XO = WS_XG + (size_t)MR * 1024 * 2;
constexpr size_t WS_MKV = WS_XO + (size_t)MR * 1024 * 2;
constexpr size_t WS_ZS = WS_MKV + (size_t)4 * 2048 * 1024 * 2;
constexpr size_t WS_XBC = WS_ZS + (size_t)MR * 2048 * 2;
constexpr size_t WS_XBCC = WS_XBC + (size_t)MR * 3072 * 2;
constexpr size_t WS_DT = WS_XBCC + (size_t)MR * 3072 * 2;
constexpr size_t WS_YZ = WS_DT + (size_t)MR * 32 * 4;
constexpr size_t WS_YN = WS_YZ + (size_t)MR * 2048 * 2;
constexpr size_t PART_STRIDE = 4096 + 64;
constexpr size_t WS_PART = WS_YN + (size_t)MR * 2048 * 2;
constexpr size_t WS_XR = WS_PART + (size_t)32 * 64 * PART_STRIDE * 4;
constexpr size_t WS_GS = WS_XR + (size_t)MR * 1024 * 2;
constexpr size_t WS_RS = WS_GS + (size_t)MR * 4 * 4;
constexpr size_t WS_END = WS_RS + (size_t)MR * 4;

constexpr int LDS_BYTES = 147456, RING_BYTES = 131072, MISC_OFF = LDS_BYTES - 256;
constexpr int CW_BAR = 4096;
#define XB_TMO      128
#define XB_XCNT(j)  (256  + 64 * (j))
#define XB_XSUB(j)  (1280 + 64 * (j))
#define XB_XGEN(j)  (2304 + 64 * (j))
#define XB_TOP      3328
#define XB_TOPGEN   3392
#define XCD_BAR_WORDS 3456
#define XB_SPIN_CAP (1u << 18)

__device__ __forceinline__ unsigned xb_ld(unsigned* p)              { return __hip_atomic_load(p, __ATOMIC_RELAXED, __HIP_MEMORY_SCOPE_AGENT); }
__device__ __forceinline__ unsigned xb_add(unsigned* p, unsigned v) { return __hip_atomic_fetch_add(p, v, __ATOMIC_RELAXED, __HIP_MEMORY_SCOPE_AGENT); }
__device__ __forceinline__ unsigned xb_xcc_id() { return (unsigned)__builtin_amdgcn_s_getreg((3 << 11) | 20) & 0xFu; }
#define XB_SPIN(cond, bar) do { unsigned _sp = 0; while (cond) { __builtin_amdgcn_s_sleep(1); \
    if ((++_sp & 255u) == 0u) { if (xb_ld(&(bar)[XB_TMO])) break; if (_sp > XB_SPIN_CAP) { atomicAdd(&(bar)[XB_TMO], 1u); break; } } } } while (0)

struct XcdBarrier {
    unsigned* bar; unsigned x;
    volatile LAS unsigned* st;
};

__device__ __forceinline__ XcdBarrier xcd_barrier_post(unsigned* bar, volatile LAS unsigned* st, int tid) {
    XcdBarrier b; b.bar = bar; b.x = xb_xcc_id(); b.st = st;
    if (tid == 0) (void)xb_add(&bar[XB_XCNT(b.x)], 1u);
    return b;
}
__device__ __forceinline__ void xcd_barrier_complete(unsigned* bar, unsigned x, unsigned& nloc, unsigned& nx) {
    const unsigned G = gridDim.x * gridDim.y * gridDim.z;
    unsigned sum, cnt, mine, sp = 0u;
    for (;;) {
        sum = 0u; cnt = 0u; mine = 0u;
#pragma unroll
        for (unsigned j = 0; j < 16; ++j) { const unsigned c = xb_ld(&bar[XB_XCNT(j)]); sum += c; cnt += (c > 0u) ? 1u : 0u; mine = (j == x) ? c : mine; }
        if (sum == G) break;
        __builtin_amdgcn_s_sleep(1);
        if ((++sp & 255u) == 0u) { if (xb_ld(&bar[XB_TMO])) break; if (sp > XB_SPIN_CAP) { atomicAdd(&bar[XB_TMO], 1u); break; } }
    }
    nloc = mine > 0u ? mine : 1u; nx = cnt > 0u ? cnt : 1u;
}

__device__ __forceinline__ void xcd_barrier(const XcdBarrier& b, int tid) {
    asm volatile("s_waitcnt vmcnt(0)" ::: "memory");
    __syncthreads();
    if (tid == 0) {
        unsigned* bar = b.bar;
        __builtin_amdgcn_s_waitcnt(0);
        unsigned nloc = b.st[0], nx = b.st[1];
        if (nloc == 0u) { xcd_barrier_complete(bar, b.x, nloc, nx); b.st[0] = nloc; b.st[1] = nx; }
        const unsigned old = xb_add(&bar[XB_XSUB(b.x)], 1u);
        const unsigned gen = old / nloc;
        if (old + 1u == (gen + 1u) * nloc) {
            __builtin_amdgcn_fence(__ATOMIC_RELEASE, "agent");
            asm volatile("s_waitcnt vmcnt(0)" ::: "memory");
            const unsigned og = xb_add(&bar[XB_TOP], 1u);
            const unsigned tg = og / nx;
            if (og + 1u == (tg + 1u) * nx) xb_add(&bar[XB_TOPGEN], 1u);
            else XB_SPIN(xb_ld(&bar[XB_TOPGEN]) == tg, bar);
            __builtin_amdgcn_fence(__ATOMIC_ACQUIRE, "agent");
            xb_add(&bar[XB_XGEN(b.x)], 1u);
            asm volatile("s_waitcnt vmcnt(0)" ::: "memory");
        } else {
            XB_SPIN(xb_ld(&bar[XB_XGEN(b.x)]) == gen, bar);
            __builtin_amdgcn_fence(__ATOMIC_ACQUIRE, "agent");
            asm volatile("s_waitcnt vmcnt(0)" ::: "memory");
        }
    }
    __syncthreads();
}
struct Params { const float* in[39]; float* out; unsigned char* ws; int ph_lo, ph_hi; };
struct Ctx { LAS unsigned char* lds; int tid, lane, wave, G, cu, gw, NGW; };

#define IN_XP 0
#define IN_XS 1
#define IN_MEM 2
#define IN_CCKV 3
#define IN_CKR 4
#define IN_PT 5
#define IN_SCA 6
#define IN_SCC 7
#define IN_SSM 8
#define IN_CMK 9
#define IN_CMV 10
#define IN_NPM 11
#define IN_NQM 12
#define IN_NPX 13
#define IN_NQX 14
#define IN_NMEM 15
#define IN_XWQG 16
#define IN_XWK 17
#define IN_XWV 18
#define IN_XWO 19
#define IN_EWIN 20
#define IN_ECW 21
#define IN_ECB 22
#define IN_ELNW 23
#define IN_ELNB 24
#define IN_EQN 25
#define IN_EKVN 26
#define IN_EWUQ 27
#define IN_EWUK 28
#define IN_EWUV 29
#define IN_EWOUT 30
#define IN_OWIN 31
#define IN_OCW 32
#define IN_OCB 33
#define IN_ODTB 34
#define IN_OALOG 35
#define IN_OD 36
#define IN_ONORM 37
#define IN_OWOUT 38

template <int W> __device__ __forceinline__ void store_bf(bf16* dst, const float (&v)[W]) {
    if constexpr (W == 8) { u32x4 w; w.x = pk2(v[0], v[1]); w.y = pk2(v[2], v[3]); w.z = pk2(v[4], v[5]); w.w = pk2(v[6], v[7]); *(u32x4*)dst = w; }
    else if constexpr (W == 4) { u32x2 w; w.x = pk2(v[0], v[1]); w.y = pk2(v[2], v[3]); *(u32x2*)dst = w; }
    else { static_assert(W == 2, "W"); *(unsigned*)dst = pk2(v[0], v[1]); }
}

template <class F> struct Epi8 {
    static constexpr bool PERM = true, AFTER_DRAIN = false, KGROUP = false;
    F f; const float* rs;
    __device__ __forceinline__ void operator()(const pg8::f32x4 (&acc)[2][2][4][2], const pg8::Unit& u, int wr, int wc, int fr, int fq) const {
        const int row0 = u.pm * 256 + wr * 64 + fr, col0 = u.pn * 256 + wc * 32 + 8 * fq;
#pragma unroll
        for (int ai = 0; ai < 2; ++ai) {
            float s4[4] = {1.f, 1.f, 1.f, 1.f};
            if (rs) {
#pragma unroll
                for (int m = 0; m < 4; ++m) s4[m] = rs[row0 + ai * 128 + m * 16]; }
#pragma unroll
            for (int m = 0; m < 4; ++m)
#pragma unroll
                for (int bj = 0; bj < 2; ++bj) { const float s = s4[m];
                    const float v[8] = {acc[ai][bj][m][0][0] * s, acc[ai][bj][m][0][1] * s, acc[ai][bj][m][0][2] * s, acc[ai][bj][m][0][3] * s,
                                        acc[ai][bj][m][1][0] * s, acc[ai][bj][m][1][1] * s, acc[ai][bj][m][1][2] * s, acc[ai][bj][m][1][3] * s};
                    f.template operator()<8>(row0 + ai * 128 + m * 16, col0 + bj * 128, v);
                }
        }
    }
};

struct EpiGN {
    static constexpr bool PERM = true, AFTER_DRAIN = false, KGROUP = true;
    bf16* O; const float* GS;
    __device__ __forceinline__ void unit_begin(const pg8::Unit& u, PG8_LAS unsigned char* lds, int wr, int fr) const {
        int fr_ = fr; asm volatile("" : "+v"(fr_));
        PG8_LAS f32x4* T = (PG8_LAS f32x4*)(lds + RING_BYTES) + (wr * 128 + fr_) * 2;
        const float* gp = GS + (size_t)(u.pm * 256 + wr * 64 + fr_) * 4;
#pragma unroll 1
        for (int i = 0; i < 8; ++i) {
            const f32x4 s = *(const f32x4*)(gp + (size_t)((i >> 2) * 128 + (i & 3) * 16) * 4);
            const float q0 = s.x * (1.f / 512.f) + EPS, q1 = s.y * (1.f / 512.f) + EPS, q2 = s.z * (1.f / 512.f) + EPS, q3 = s.w * (1.f / 512.f) + EPS;
            const float r0 = rsqrtf(q0), r1 = rsqrtf(q1), r2 = rsqrtf(q2), r3 = rsqrtf(q3);
            T[i * 32] = (f32x4){1.f, r0 * (q1 * r1), r1 * (q2 * r2), r2 * (q3 * r3)}; T[i * 32 + 1] = (f32x4){r3, 0.f, 0.f, 0.f};
        }
    }
    __device__ __forceinline__ void kgroup(pg8::f32x4 (&acc)[2][2][4][2], PG8_LAS unsigned char* lds, int g, int wr, int fr) const {
        int fr_ = fr; asm volatile("" : "+v"(fr_));
        const unsigned tb_ = (unsigned)(RING_BYTES + wr * 4096 + fr_ * 32 + g * 4);
        const PG8_LAS float* T = (const PG8_LAS float*)(lds + tb_);
#pragma unroll
        for (int ai = 0; ai < 2; ++ai)
#pragma unroll
            for (int m = 0; m < 4; ++m) { const float r = T[(ai * 64 + m * 16) * 8];
#pragma unroll
                for (int bj = 0; bj < 2; ++bj)
#pragma unroll
                    for (int n = 0; n < 2; ++n) acc[ai][bj][m][n] *= r; }
    }
    PG8_LAS unsigned char* ldsb; int multi;
    __device__ __forceinline__ void operator()(const pg8::f32x4 (&acc)[2][2][4][2], const pg8::Unit& u, int wr, int wc, int fr, int fq) const {
        const int row0 = u.pm * 256 + wr * 64 + fr, col0 = u.pn * 256 + wc * 32 + 8 * fq;
        int fr_ = fr; asm volatile("" : "+v"(fr_));
        const unsigned tb_ = (unsigned)(RING_BYTES + wr * 4096 + fr_ * 32 + 16);
        const PG8_LAS float* T = (const PG8_LAS float*)(ldsb + tb_);
#pragma unroll
        for (int ai = 0; ai < 2; ++ai)
#pragma unroll
            for (int m = 0; m < 4; ++m) { const int row = row0 + ai * 128 + m * 16;
                const float r3 = multi ? rsqrtf(GS[(size_t)row * 4 + 3] * (1.f / 512.f) + EPS) : T[(ai * 64 + m * 16) * 8];
#pragma unroll
                for (int bj = 0; bj < 2; ++bj) {
                    const float v[8] = {acc[ai][bj][m][0][0] * r3, acc[ai][bj][m][0][1] * r3, acc[ai][bj][m][0][2] * r3, acc[ai][bj][m][0][3] * r3,
                                        acc[ai][bj][m][1][0] * r3, acc[ai][bj][m][1][1] * r3, acc[ai][bj][m][1][2] * r3, acc[ai][bj][m][1][3] * r3};
                    store_bf<8>(O + (size_t)row * 1024 + col0 + bj * 128, v); } }
    }
};

template <bool GN = false, class F>
__device__ __forceinline__ void skinny_unit(const Ctx& c, const bf16* A, int lda, const bf16* Bt, int ldb, int K, int rowT0, int colT0, int rowT1, int colT1, const F& f, const float* rs = nullptr) {
    const int lane = c.lane, r32 = lane & 31, hi = lane >> 5, w = c.wave, tile = w & 1, ks = w >> 1;
    const int row0 = tile ? rowT1 : rowT0, col0 = tile ? colT1 : colT0, Ks = K >> 2;
    const bf16* ap = A + (size_t)(row0 + r32) * lda + ks * Ks + 8 * hi;
    const bf16* bp = Bt + (size_t)(col0 + r32) * ldb + ks * Ks + 8 * hi;
    f32x16 acc = {}; float gss = 0.f;
#pragma unroll 2
    for (int k = 0; k < Ks; k += 64) {
        const bf16x8 a0 = *(const bf16x8*)(ap + k), a1 = *(const bf16x8*)(ap + k + 16), a2 = *(const bf16x8*)(ap + k + 32), a3 = *(const bf16x8*)(ap + k + 48);
        const bf16x8 b0 = *(const bf16x8*)(bp + k), b1 = *(const bf16x8*)(bp + k + 16), b2 = *(const bf16x8*)(bp + k + 32), b3 = *(const bf16x8*)(bp + k + 48);
        acc = mfma32(b0, a0, acc); acc = mfma32(b1, a1, acc); acc = mfma32(b2, a2, acc); acc = mfma32(b3, a3, acc);
        if constexpr (GN) {
#pragma unroll
            for (int j = 0; j < 8; ++j) { const float x0 = bf2f((unsigned short)a0[j]), x1 = bf2f((unsigned short)a1[j]), x2 = bf2f((unsigned short)a2[j]), x3 = bf2f((unsigned short)a3[j]); gss += (x0 * x0 + x1 * x1) + (x2 * x2 + x3 * x3); } }
    }
    if constexpr (GN) { gss += xhalf(gss); acc *= rsqrtf(gss * (1.f / 512.f) + EPS); }
    LAS float* P = (LAS float*)c.lds;
#pragma unroll
    for (int r = 0; r < 16; ++r) P[(w * 16 + r) * 64 + lane] = acc[r];
    __syncthreads();
    {
        const int g = w >> 1; float v[4];
#pragma unroll
        for (int i = 0; i < 4; ++i) { const int r = 4 * g + i; v[i] = (P[((tile + 0) * 16 + r) * 64 + lane] + P[((tile + 2) * 16 + r) * 64 + lane]) + (P[((tile + 4) * 16 + r) * 64 + lane] + P[((tile + 6) * 16 + r) * 64 + lane]); }
        if (rs) { const float s = rs[row0 + r32];
#pragma unroll
            for (int i = 0; i < 4; ++i) v[i] *= s; }
        f.template operator()<4>(row0 + r32, col0 + 8 * g + 4 * hi, v);
    }
    __syncthreads();
}
template <bool GN = false, class F>
__device__ __forceinline__ void skinny_sample(const Ctx& c, const bf16* A, int lda, const bf16* Bt, int ldb, int K, int ncols, const F& f, int cu_rot, const float* rs = nullptr) {
    const int vc = (c.cu + c.G - cu_rot % c.G) % c.G;
    for (int u = vc; u < (ncols / 64) * 4; u += c.G) { const bf16* Au = A; asm volatile("" : "+s"(Au));
        const int rb = u & 3, cp = u >> 2; skinny_unit<GN>(c, Au, lda, Bt, ldb, K, MP + 32 * rb, 64 * cp, MP + 32 * rb, 64 * cp + 32, f, rs); }
}

struct FGemm1 {
    bf16 *GLU, *GATE, *CQ, *KVRAW;
    template <int W> __device__ __forceinline__ void operator()(int row, int col, const float (&v)[W]) const {
        if (col < 1024) { float o[W / 2];
#pragma unroll
            for (int i = 0; i < W / 2; ++i) o[i] = v[2 * i] * sigmoidf_(v[2 * i + 1]);
            store_bf<W / 2>(GLU + (size_t)row * 512 + (col >> 1), o); }
        else if (col < 1536) { float o[W];
#pragma unroll
            for (int i = 0; i < W; ++i) o[i] = siluf_(v[i]);
            store_bf<W>(GATE + (size_t)row * 1024 + (col - 1024), o); }
        else if (col < 1792) store_bf<W>(CQ + (size_t)row * 256 + (col - 1536), v);
        else if (col < 2304) { float o[W];
#pragma unroll
            for (int i = 0; i < W; ++i) o[i] = siluf_(v[i]);
            store_bf<W>(GATE + (size_t)row * 1024 + 512 + (col - 1792), o); }
        else store_bf<W>(KVRAW + (size_t)row * 256 + (col - 2304), v);
    }
};
struct FMemKV {
    float *OK, *OV; bf16 *BK, *BV;
    template <int W> __device__ __forceinline__ void operator()(int row, int col, const float (&v)[W]) const {
        float* o = (col < 1024) ? OK + (size_t)row * 1024 + col : OV + (size_t)row * 1024 + (col - 1024);
        bf16* b = (col < 1024) ? BK + (size_t)row * 1024 + col : BV + (size_t)row * 1024 + (col - 1024);
#pragma unroll
        for (int i = 0; i < W; i += 4) *(f32x4*)(o + i) = (f32x4){v[i], v[i + 1], v[i + 2], v[i + 3]};
        store_bf<W>(b, v);
    }
};
__device__ __forceinline__ int pos_index(int row) { return row < MP ? (row & (TP - 1)) : TP + ((row - MP) & 3); }
struct FQ {
    bf16* QP; const float* ROPE;
    template <int W> __device__ __forceinline__ void operator()(int row, int col, const float (&v)[W]) const {
        float o[W];
        if (col < 1024) {
#pragma unroll
            for (int i = 0; i < W; ++i) o[i] = v[i] * C_MLA;
        } else { const float* rp = ROPE + ((size_t)pos_index(row) * 16 + (((col - 1024) & 31) >> 1)) * 2;
#pragma unroll
            for (int i = 0; i < W / 2; ++i) { const float cs = rp[2 * i], sn = rp[2 * i + 1], x1 = v[2 * i] * C_MLA, x2 = v[2 * i + 1] * C_MLA; o[2 * i] = x1 * cs - x2 * sn; o[2 * i + 1] = x1 * sn + x2 * cs; }
        }
        store_bf<W>(QP + (size_t)row * 1280 + col, o);
    }
};
struct FPlain { bf16* O; int ldo;
    template <int W> __device__ __forceinline__ void operator()(int row, int col, const float (&v)[W]) const { store_bf<W>(O + (size_t)row * ldo + col, v); }
};
struct FQG {
    bf16 *XQ, *XG;
    template <int W> __device__ __forceinline__ void operator()(int row, int col, const float (&v)[W]) const {
        float o[W];
        if (col < 1024) {
#pragma unroll
            for (int i = 0; i < W; ++i) o[i] = v[i] * C_X;
            store_bf<W>(XQ + (size_t)row * 1024 + col, o);
        } else {
#pragma unroll
            for (int i = 0; i < W; ++i) o[i] = siluf_(v[i]);
            store_bf<W>(XG + (size_t)row * 1024 + (col - 1024), o);
        }
    }
};
struct FOIn {
    bf16 *ZS, *XBC;
    template <int W> __device__ __forceinline__ void operator()(int row, int col, const float (&v)[W]) const {
        if (col < 2048) { float o[W];
#pragma unroll
            for (int i = 0; i < W; ++i) o[i] = siluf_(v[i]);
            store_bf<W>(ZS + (size_t)row * 2048 + col, o); }
        else store_bf<W>(XBC + (size_t)row * 3072 + (col - 2048), v);
    }
};
struct FDt {
    float* DT; const float* bias;
    template <int W> __device__ __forceinline__ void operator()(int row, int col, const float (&v)[W]) const {
#pragma unroll
        for (int i = 0; i < W; ++i) { const float x = v[i] + bias[col + i]; DT[(size_t)row * 32 + col + i] = x > 20.f ? x : log1pf(__expf(x)); }
    }
};
__device__ __forceinline__ int ein_src_col(int n) {
    if (n < 1024) return (n & 1) ? 512 + (n >> 1) : (n >> 1);
    if (n < 1792) return n;
    if (n < 2304) return 1952 + (n - 1792);
    if (n < 2464) return 1792 + (n - 2304);
    return -1;
}
__device__ __forceinline__ void transpose_item(const float* W, int K, int N, bf16* WT, int drows, int kind, int coff, int item, LAS float* scr, int lane, const float* kscale = nullptr) {
    const int nblk = drows / 32, kb = item / nblk, nb = item % nblk, k0 = 64 * kb, n0 = 32 * nb;
    const int nd = n0 + (lane & 31);
    const int sn = kind == 1 ? ein_src_col(nd) : nd + coff;
#pragma unroll 8
    for (int i = 0; i < 32; ++i) { const int kk = 2 * i + (lane >> 5); float v_ = sn >= 0 ? W[(size_t)(k0 + kk) * N + sn] : 0.f; if (kscale) v_ *= kscale[k0 + kk]; scr[kk * 33 + (lane & 31)] = v_; }
    LDS_WAIT(); asm volatile("" ::: "memory");
    const int c = lane & 7;
#pragma unroll
    for (int j = 0; j < 4; ++j) { const int n = (lane >> 3) + 8 * j; const LAS float* s = scr + (8 * c) * 33 + n;
        u32x4 o; o.x = pk2(s[0 * 33], s[1 * 33]); o.y = pk2(s[2 * 33], s[3 * 33]); o.z = pk2(s[4 * 33], s[5 * 33]); o.w = pk2(s[6 * 33], s[7 * 33]);
        *(u32x4*)(WT + (size_t)(n0 + n) * K + k0 + 8 * c) = o; }
    LDS_WAIT(); asm volatile("" ::: "memory");
}
__device__ __forceinline__ void rms_row_to_bf16(const float* xrow, const float* w, bf16* orow, int lane) {
    const f32x4* xr = (const f32x4*)xrow + lane; const f32x4* wr = (const f32x4*)w + lane;
    f32x4 v[4]; float s = 0.f;
#pragma unroll
    for (int j = 0; j < 4; ++j) { v[j] = xr[64 * j]; s += (v[j].x * v[j].x + v[j].y * v[j].y) + (v[j].z * v[j].z + v[j].w * v[j].w); }
    const float r = rsqrtf(wave_sum(s) * (1.f / 1024.f) + EPS);
    u32x2* o8 = (u32x2*)orow + lane;
#pragma unroll
    for (int j = 0; j < 4; ++j) { const f32x4 ww = wr[64 * j]; u32x2 o; o.x = pk2(v[j].x * r * ww.x, v[j].y * r * ww.y); o.y = pk2(v[j].z * r * ww.z, v[j].w * r * ww.w); o8[64 * j] = o; }
}
__device__ __forceinline__ void row_to_bf16_stat(const float* xrow, bf16* orow, float* rstd, int lane) {
    const f32x4* xr = (const f32x4*)xrow + lane;
    f32x4 v[4]; float s = 0.f;
#pragma unroll
    for (int j = 0; j < 4; ++j) { v[j] = xr[64 * j]; s += (v[j].x * v[j].x + v[j].y * v[j].y) + (v[j].z * v[j].z + v[j].w * v[j].w); }
    const float r = rsqrtf(wave_sum(s) * (1.f / 1024.f) + EPS);
    u32x2* o8 = (u32x2*)orow + lane;
#pragma unroll
    for (int j = 0; j < 4; ++j) { u32x2 o; o.x = pk2(v[j].x, v[j].y); o.y = pk2(v[j].z, v[j].w); o8[64 * j] = o; }
    if (lane == 0) *rstd = r;
}
template <bool OUT32>
__device__ __forceinline__ void resid_row(const bf16* xi, const bf16* y, const float* wpost, void* xo, float* rstd, int lane) {
    const u32x2* yr = (const u32x2*)y + lane; const f32x4* wq = (const f32x4*)wpost + lane;
    f32x4 yv[4]; float s = 0.f;
#pragma unroll
    for (int j = 0; j < 4; ++j) { const u32x2 t = yr[64 * j]; yv[j] = (f32x4){bflo(t.x), bfhi(t.x), bflo(t.y), bfhi(t.y)}; s += (yv[j].x * yv[j].x + yv[j].y * yv[j].y) + (yv[j].z * yv[j].z + yv[j].w * yv[j].w); }
    f32x4 xv[4];
#pragma unroll
    for (int j = 0; j < 4; ++j) { const u32x2 t = ((const u32x2*)xi + lane)[64 * j]; xv[j] = (f32x4){bflo(t.x), bfhi(t.x), bflo(t.y), bfhi(t.y)}; }
    const float r = rsqrtf(wave_sum(s) * (1.f / 1024.f) + EPS);
    float s2 = 0.f;
#pragma unroll
    for (int j = 0; j < 4; ++j) { const f32x4 ww = wq[64 * j]; xv[j] = xv[j] + yv[j] * r * ww;
        if constexpr (!OUT32) { u32x2 o; o.x = pk2(xv[j].x, xv[j].y); o.y = pk2(xv[j].z, xv[j].w); ((u32x2*)xo + lane)[64 * j] = o;
            const f32x4 q = (f32x4){bflo(o.x), bfhi(o.x), bflo(o.y), bfhi(o.y)}; s2 += (q.x * q.x + q.y * q.y) + (q.z * q.z + q.w * q.w); }
        else ((f32x4*)xo + lane)[64 * j] = xv[j]; }
    if constexpr (!OUT32) { const float r2 = rsqrtf(wave_sum(s2) * (1.f / 1024.f) + EPS); if (lane == 0) *rstd = r2; }
}
template <bool LAST>
__device__ __forceinline__ void phase_resid(const Params& p, const Ctx& c, const float* wpost) {
    unsigned char* ws = p.ws; const bf16* YB = (const bf16*)(ws + WS_YB); bf16* XR = (bf16*)(ws + WS_XR); float* RS = (float*)(ws + WS_RS);
    for (int r = c.gw; r < MT; r += c.NGW) {
        if constexpr (!LAST) resid_row<false>(XR + (size_t)r * DM, YB + (size_t)r * DM, wpost, XR + (size_t)r * DM, RS + r, c.lane);
        else resid_row<true>(XR + (size_t)r * DM, YB + (size_t)r * DM, wpost, p.out + (size_t)r * DM, nullptr, c.lane);
    }
}

__device__ __forceinline__ void phase_prep(const Params& p, const Ctx& c) {
    unsigned char* ws = p.ws;
    LAS float* scr = (LAS float*)(c.lds + c.wave * 16384);
    constexpr int J0 = 16 * 80, J1 = 16 * 32, J5 = 16 * 32, J6 = 16 * 64, J8 = 16 * 32, J10 = 16 * 160, J11 = 16 * 1, J12 = 32 * 32;
    constexpr int NIT = J0 + 4 * J1 + J5 + 2 * J6 + 2 * J8 + J10 + J11 + J12;
    for (int it = c.gw; it < NIT; it += c.NGW) {
        int r = it;
        if (r < J0) { transpose_item(p.in[IN_EWIN], 1024, 2464, (bf16*)(ws + WS_WEIN), 2560, 1, 0, r, scr, c.lane, p.in[IN_NPM]); continue; } r -= J0;
        if (r < 4 * J1) { const int q = r / J1, i = q >> 1, kv = q & 1;
            transpose_item(p.in[kv ? IN_XWV : IN_XWK] + (size_t)i * 1024 * 1024, 1024, 1024, (bf16*)(ws + WS_WMKV) + (size_t)(i * 2048 + kv * 1024) * 1024, 1024, 0, 0, r % J1, scr, c.lane); continue; } r -= 4 * J1;
        if (r < J5) { transpose_item(p.in[IN_EWOUT], 1024, 1024, (bf16*)(ws + WS_WEOUT), 1024, 0, 0, r, scr, c.lane); continue; } r -= J5;
        if (r < 2 * J6) { const int i = r / J6; transpose_item(p.in[IN_XWQG] + (size_t)i * 1024 * 2048, 1024, 2048, (bf16*)(ws + WS_WQG) + (size_t)i * 2048 * 1024, 2048, 0, 0, r % J6, scr, c.lane, p.in[IN_NPX] + i * DM); continue; } r -= 2 * J6;
        if (r < 2 * J8) { const int i = r / J8; transpose_item(p.in[IN_XWO] + (size_t)i * 1024 * 1024, 1024, 1024, (bf16*)(ws + WS_WXO) + (size_t)i * 1024 * 1024, 1024, 0, 0, r % J8, scr, c.lane); continue; } r -= 2 * J8;
        if (r < J10) { transpose_item(p.in[IN_OWIN], 1024, 5152, (bf16*)(ws + WS_WOIN), 5120, 0, 0, r, scr, c.lane, p.in[IN_NPM] + DM); continue; } r -= J10;
        if (r < J11) { transpose_item(p.in[IN_OWIN], 1024, 5152, (bf16*)(ws + WS_WDT), 32, 0, 5120, r, scr, c.lane, p.in[IN_NPM] + DM); continue; } r -= J11;
        transpose_item(p.in[IN_OWOUT], 2048, 1024, (bf16*)(ws + WS_WOOUT), 1024, 0, 0, r, scr, c.lane, p.in[IN_ONORM]);
    }
    const int gt = c.gw * 64 + c.lane, NGT = c.NGW * 64;
    { const float* wuq = p.in[IN_EWUQ]; const float* wuk = p.in[IN_EWUK]; bf16* WQ = (bf16*)(ws + WS_WQ);
      for (int idx = gt; idx < 1280 * 256; idx += NGT) { const int r = idx & 255, n = idx >> 8; float v;
          if (n < 1024) { const int h = n >> 7, cc = n & 127; const f32x4* a = (const f32x4*)(wuq + (size_t)(r * 8 + h) * 96); const f32x4* b = (const f32x4*)(wuk + (size_t)(cc * 8 + h) * 64); float s = 0.f;
#pragma unroll
              for (int i = 0; i < 16; ++i) { const f32x4 x = a[i], y = b[i]; s += (x.x * y.x + x.y * y.y) + (x.z * y.z + x.w * y.w); }
              v = s; }
          else { const int h = (n - 1024) >> 5, e = (n - 1024) & 31; v = wuq[(size_t)(r * 8 + h) * 96 + 64 + (e >> 1) + 16 * (e & 1)]; }
          WQ[(size_t)n * 256 + r] = (bf16)f2bf(v); } }
    { const float* wuv = p.in[IN_EWUV]; bf16* WT = (bf16*)(ws + WS_WUVT);
      for (int idx = gt; idx < 8 * 64 * 128; idx += NGT) { const int cc = idx & 127, v = (idx >> 7) & 63, h = idx >> 13; WT[idx] = (bf16)f2bf(wuv[(size_t)(cc * 8 + h) * 64 + v]); } }
    { float* GSz = (float*)(ws + WS_GS); for (int idx = gt; idx < MR * 4; idx += NGT) GSz[idx] = 0.f; }
    { float* R = (float*)(ws + WS_ROPE);
      for (int idx = gt; idx < 2052 * 16; idx += NGT) { const int pi = idx >> 4, j = idx & 15; const float pos = (float)(pi < TP ? pi : 16384 + (pi - TP));
          const float inv = powf(10000.f, -(float)j / 16.f); float sn, cs; sincosf(pos * inv, &sn, &cs); R[2 * idx] = cs; R[2 * idx + 1] = sn; } }
    bf16* MN = (bf16*)(ws + WS_MN);
    for (int r = c.gw; r < MT + 4096; r += c.NGW) {
        if (r < MT) row_to_bf16_stat(r < MP ? p.in[IN_XP] + (size_t)r * DM : p.in[IN_XS] + (size_t)(r - MP) * DM, (bf16*)(ws + WS_XR) + (size_t)r * DM, (float*)(ws + WS_RS) + r, c.lane);
        else { const int q = r - MT, i = q >> 11, m = q & 2047; rms_row_to_bf16(p.in[IN_MEM] + (size_t)m * DM, p.in[IN_NMEM] + i * DM, MN + (size_t)(i * 2048 + m) * DM, c.lane); }
    }
}
__device__ __forceinline__ void conv_unit(const Params& p, const Ctx& c, int u) {
    unsigned char* ws = p.ws;
    const bf16* GLU = (const bf16*)(ws + WS_GLU); const bf16* GATE = (const bf16*)(ws + WS_GATE); bf16* YCAT = (bf16*)(ws + WS_YCAT);
    LAS unsigned char* G = c.lds;
    LAS float* Y = (LAS float*)(c.lds + 63488);
    const bool samp = u >= 512; const int b = samp ? u - 512 : (u >> 6), tb = samp ? 0 : (u & 63), t0 = tb * 32;
    const int tid = c.tid;
    for (int ch = tid; ch < 62 * 64; ch += 512) {
        const int r = ch >> 6, c16 = ch & 63; u32x4 v = {0u, 0u, 0u, 0u};
        if (!samp) { const int t = t0 - 30 + r; if (t >= 0) v = *(const u32x4*)(GLU + ((size_t)b * TP + t) * 512 + c16 * 8); }
        else if (r < 30) { const f32x4* s = (const f32x4*)(p.in[IN_SCA] + ((size_t)b * 30 + r) * 512 + c16 * 8); const f32x4 a = s[0], d = s[1];
            v.x = pk2(a.x, a.y); v.y = pk2(a.z, a.w); v.z = pk2(d.x, d.y); v.w = pk2(d.z, d.w); }
        else if (r < 34) v = *(const u32x4*)(GLU + ((size_t)MP + 4 * b + (r - 30)) * 512 + c16 * 8);
        *(LAS u32x4*)(G + r * 1024 + c16 * 16) = v;
    }
    __syncthreads();
    {
        const int ch = tid; const float* cw = p.in[IN_ECW]; float w[31];
#pragma unroll
        for (int k = 0; k < 31; ++k) w[k] = cw[k * 512 + ch];
        const float bias = p.in[IN_ECB][ch];
        float g[62];
#pragma unroll
        for (int r = 0; r < 62; ++r) g[r] = bf2f(*(const LAS unsigned short*)(G + r * 1024 + ch * 2));
        f32x2 ge[31], go[30];
#pragma unroll
        for (int j = 0; j < 31; ++j) ge[j] = (f32x2){g[2 * j], g[2 * j + 1]};
#pragma unroll
        for (int j = 0; j < 30; ++j) go[j] = (f32x2){g[2 * j + 1], g[2 * j + 2]};
#pragma unroll
        for (int t = 0; t < 32; t += 2) { f32x2 a = {bias, bias};
#pragma unroll
            for (int k = 0; k < 31; ++k) { const f32x2 wv = {w[k], w[k]}; const f32x2 gp = ((t + k) & 1) ? go[(t + k - 1) >> 1] : ge[(t + k) >> 1]; a = __builtin_elementwise_fma(wv, gp, a); }
            Y[t * 512 + ch] = a.x; Y[(t + 1) * 512 + ch] = a.y; }
        if (!samp) { if (tb == 63) { float* o = p.out + O_CAP + (size_t)b * 30 * 512 + ch;
#pragma unroll
                for (int i = 0; i < 30; ++i) o[i * 512] = g[32 + i]; } }
        else { float* o = p.out + O_CAS + (size_t)b * 30 * 512 + ch; const float* hs = p.in[IN_SCA] + (size_t)b * 30 * 512 + ch;
#pragma unroll
            for (int i = 0; i < 30; ++i) o[i * 512] = (i < 26) ? hs[(4 + i) * 512] : g[4 + i]; }
    }
    __syncthreads();
    {
        const int lane = c.lane, c0 = lane * 8; const int ntok = samp ? 4 : 32;
        const f32x4* lw = (const f32x4*)(p.in[IN_ELNW] + c0); const f32x4* lb = (const f32x4*)(p.in[IN_ELNB] + c0);
        const f32x4 w0 = lw[0], w1 = lw[1], b0 = lb[0], b1 = lb[1];
        for (int i = 0; i < 4; ++i) { const int t = c.wave * 4 + i; if (t >= ntok) break;
            const LAS f32x4* yp = (const LAS f32x4*)(Y + t * 512 + c0); const f32x4 y0 = yp[0], y1 = yp[1];
            const float mean = wave_sum((y0.x + y0.y) + (y0.z + y0.w) + (y1.x + y1.y) + (y1.z + y1.w)) * (1.f / 512.f);
            const f32x4 d0 = y0 - mean, d1 = y1 - mean;
            const float var = wave_sum((d0.x * d0.x + d0.y * d0.y) + (d0.z * d0.z + d0.w * d0.w) + (d1.x * d1.x + d1.y * d1.y) + (d1.z * d1.z + d1.w * d1.w)) * (1.f / 512.f);
            const float rstd = rsqrtf(var + EPS);
            const size_t row = samp ? (size_t)MP + 4 * b + t : (size_t)b * TP + t0 + t;
            const u32x4 gt = *(const u32x4*)(GATE + row * 1024 + c0);
            const f32x4 n0 = d0 * rstd * w0 + b0, n1 = d1 * rstd * w1 + b1;
            const float o[8] = {siluf_(n0.x) * bflo(gt.x), siluf_(n0.y) * bfhi(gt.x), siluf_(n0.z) * bflo(gt.y), siluf_(n0.w) * bfhi(gt.y),
                                siluf_(n1.x) * bflo(gt.z), siluf_(n1.y) * bfhi(gt.z), siluf_(n1.z) * bflo(gt.w), siluf_(n1.w) * bfhi(gt.w)};
            store_bf<8>(YCAT + row * 1024 + c0, o); }
    }
    __syncthreads();
}
__device__ __forceinline__ void kvq_row(const Params& p, const Ctx& c, int r) {
    unsigned char* ws = p.ws; const int lane = c.lane;
    const bf16* CQ = (const bf16*)(ws + WS_CQ); bf16* CQN = (bf16*)(ws + WS_CQN); const bf16* KV = (const bf16*)(ws + WS_KVRAW); bf16* KP = (bf16*)(ws + WS_KP);
    { const u32x2 t = *(const u32x2*)(CQ + (size_t)r * 256 + lane * 4); const float v0 = bflo(t.x), v1 = bfhi(t.x), v2 = bflo(t.y), v3 = bfhi(t.y);
      const float s = rsqrtf(wave_sum((v0 * v0 + v1 * v1) + (v2 * v2 + v3 * v3)) * (1.f / 256.f) + EPS); const f32x4 w = *(const f32x4*)(p.in[IN_EQN] + lane * 4);
      const float o[4] = {v0 * s * w.x, v1 * s * w.y, v2 * s * w.z, v3 * s * w.w}; store_bf<4>(CQN + (size_t)r * 256 + lane * 4, o); }
    float* ock = r < MP ? p.out + O_CKVP + (size_t)r * 128 : p.out + O_CKVS + (size_t)(r - MP) * 128;
    float* okr = r < MP ? p.out + O_KRP + (size_t)r * 32 : p.out + O_KRS + (size_t)(r - MP) * 32;
    { const unsigned t = *(const unsigned*)(KV + (size_t)r * 256 + lane * 2); const float v0 = bflo(t), v1 = bfhi(t);
      const float s = rsqrtf(wave_sum(v0 * v0 + v1 * v1) * (1.f / 128.f) + EPS); const f32x2 w = *(const f32x2*)(p.in[IN_EKVN] + lane * 2);
      const float o[2] = {v0 * s * w.x, v1 * s * w.y}; *(f32x2*)(ock + lane * 2) = (f32x2){o[0], o[1]}; store_bf<2>(KP + (size_t)r * 160 + lane * 2, o); }
    if (lane < 16) { const float x1 = bf2f(KV[(size_t)r * 256 + 128 + lane]), x2 = bf2f(KV[(size_t)r * 256 + 144 + lane]);
        const float* rp = (const float*)(ws + WS_ROPE) + ((size_t)pos_index(r) * 16 + lane) * 2; const float cs = rp[0], sn = rp[1];
        const float o[2] = {x1 * cs - x2 * sn, x1 * sn + x2 * cs}; okr[lane] = o[0]; okr[16 + lane] = o[1]; store_bf<2>(KP + (size_t)r * 160 + 128 + 2 * lane, o); }
}
__device__ __forceinline__ void phase_conv(const Params& p, const Ctx& c) {
    for (int u = c.cu; u < 512 + 32; u += c.G) conv_unit(p, c, u);
    for (int r = c.gw; r < MT; r += 2 * c.NGW) { kvq_row(p, c, r); if (r + c.NGW < MT) kvq_row(p, c, r + c.NGW); }
}
constexpr int KS = 336;
#define EXP2(x) __builtin_amdgcn_exp2f(x)
__device__ __forceinline__ void mla_prompt_unit(const Params& p, const Ctx& c, int b, int tb) {
    unsigned char* ws = p.ws;
    const bf16* QP = (const bf16*)(ws + WS_QP); const bf16* KP = (const bf16*)(ws + WS_KP); const bf16* GATE = (const bf16*)(ws + WS_GATE); bf16* YCAT = (bf16*)(ws + WS_YCAT);
    const bf16* WUVT = (const bf16*)(ws + WS_WUVT);
    const int tid = c.tid, lane = c.lane, r32 = lane & 31, hi = lane >> 5, head = c.wave, t0 = tb * 32;
    const size_t qrow = (size_t)b * TP + t0 + r32;
    bf16x8 qf[10];
#pragma unroll
    for (int s = 0; s < 8; ++s) qf[s] = *(const bf16x8*)(QP + qrow * 1280 + head * 128 + 16 * s + 8 * hi);
#pragma unroll
    for (int s = 0; s < 2; ++s) qf[8 + s] = *(const bf16x8*)(QP + qrow * 1280 + 1024 + head * 32 + 16 * s + 8 * hi);
    f32x16 o0 = {}, o1 = {}, o2 = {}, o3 = {}; float m = -1e30f, l = 0.f;
    const int ntile = (t0 + 32 + 63) >> 6;
    const bf16* kbase = KP + (size_t)b * TP * 160;
    u32x4 rg[3];
    const unsigned gvo = (unsigned)tid * 16u;
    const int lo0 = (tid / 20) * KS + (tid % 20) * 16, lo1 = ((tid + 512) / 20) * KS + ((tid + 512) % 20) * 16, lo2 = ((tid + 1024) / 20) * KS + ((tid + 1024) % 20) * 16;
#define MLA_LOAD(j) do { const char* t_ = (const char*)kbase + (size_t)(j) * 20480; rg[0] = *(const u32x4*)(t_ + gvo); rg[1] = *(const u32x4*)(t_ + gvo + 8192); if (tid < 256) rg[2] = *(const u32x4*)(t_ + gvo + 16384); } while (0)
#define MLA_STORE(buf) do { *(LAS u32x4*)((buf) + lo0) = rg[0]; *(LAS u32x4*)((buf) + lo1) = rg[1]; if (tid < 256) *(LAS u32x4*)((buf) + lo2) = rg[2]; } while (0)
    MLA_LOAD(0); MLA_STORE(c.lds); __syncthreads();
    const int vofs = (4 * hi + ((lane & 15) >> 2)) * KS + (((lane >> 4) & 1) * 16 + (lane & 3) * 4) * 2;
    for (int j = 0; j < ntile; ++j) {
        asm volatile("; MLA_TILE_BEGIN");
        LAS unsigned char* cur = c.lds + (j & 1) * (64 * KS); LAS unsigned char* nxt = c.lds + ((j + 1) & 1) * (64 * KS);
        if (j + 1 < ntile) MLA_LOAD(j + 1);
        const bool two = (64 * j + 32 <= t0 + 31);
        f32x16 p0 = {}, p1 = {};
        const LAS unsigned char* ka = cur + r32 * KS + hi * 16;
        { bf16x8 kf[10];
#pragma unroll
          for (int s = 0; s < 10; ++s) kf[s] = *(const LAS bf16x8*)(ka + s * 32);
          SCHED_FENCE(); PRIO_HI();
#pragma unroll
          for (int s = 0; s < 10; ++s) p0 = mfma32(kf[s], qf[s], p0);
          PRIO_LO(); SCHED_FENCE();
          if (two) {
#pragma unroll
            for (int s = 0; s < 10; ++s) kf[s] = *(const LAS bf16x8*)(ka + 32 * KS + s * 32);
            SCHED_FENCE(); PRIO_HI();
#pragma unroll
            for (int s = 0; s < 10; ++s) p1 = mfma32(kf[s], qf[s], p1);
            PRIO_LO(); SCHED_FENCE();
          } }
        if (64 * j + 63 > t0) { const int t = t0 + r32;
#pragma unroll
            for (int r = 0; r < 16; ++r) { const int key = 64 * j + crow(r, hi); if (key > t) p0[r] = -INFINITY; if (key + 32 > t) p1[r] = -INFINITY; } }
        float mx = max2f(p0[0], p1[0]);
#pragma unroll
        for (int r = 1; r < 16; ++r) mx = max3f(mx, p0[r], p1[r]);
        mx = max2f(mx, xhalf(mx));
        if (__builtin_amdgcn_ballot_w64(mx > m) != 0ull) {
            const float mn = max2f(m, mx), alpha = EXP2(m - mn); m = mn;
            l *= alpha; o0 *= alpha; o1 *= alpha; o2 *= alpha; o3 *= alpha;
        }
        float rs = 0.f;
#pragma unroll
        for (int r = 0; r < 16; ++r) { p0[r] = EXP2(p0[r] - m); p1[r] = EXP2(p1[r] - m); rs += p0[r] + p1[r]; }
        l += rs;
        const bf16x8 pf0 = pack8(p0[0], p0[1], p0[2], p0[3], p0[4], p0[5], p0[6], p0[7]), pf1 = pack8(p0[8], p0[9], p0[10], p0[11], p0[12], p0[13], p0[14], p0[15]);
        const bf16x8 pf2 = pack8(p1[0], p1[1], p1[2], p1[3], p1[4], p1[5], p1[6], p1[7]), pf3 = pack8(p1[8], p1[9], p1[10], p1[11], p1[12], p1[13], p1[14], p1[15]);
        const LAS unsigned char* va = cur + vofs;
#define MLA_PV(ks, pf) do { const LAS unsigned char* v_ = va + (16 * (ks)) * KS; \
            const s16x4 a0_ = tr_read(v_), a1_ = tr_read(v_ + 8 * KS), b0_ = tr_read(v_ + 64), b1_ = tr_read(v_ + 8 * KS + 64), c0_ = tr_read(v_ + 128), c1_ = tr_read(v_ + 8 * KS + 128), d0_ = tr_read(v_ + 192), d1_ = tr_read(v_ + 8 * KS + 192); \
            SCHED_FENCE(); PRIO_HI(); \
            o0 = mfma32(cat4(a0_, a1_), pf, o0); o1 = mfma32(cat4(b0_, b1_), pf, o1); o2 = mfma32(cat4(c0_, c1_), pf, o2); o3 = mfma32(cat4(d0_, d1_), pf, o3); \
            PRIO_LO(); SCHED_FENCE(); } while (0)
        MLA_PV(0, pf0); MLA_PV(1, pf1);
        if (two) { MLA_PV(2, pf2); MLA_PV(3, pf3); }
        if (j + 1 < ntile) MLA_STORE(nxt);
        __syncthreads();
        asm volatile("; MLA_TILE_END");
    }
    l += xhalf(l); const float inv = 1.f / l;
    o0 *= inv; o1 *= inv; o2 *= inv; o3 *= inv;
    f32x16 y0 = {}, y1 = {};
    const bf16* wp = WUVT + (size_t)head * 64 * 128 + r32 * 128 + 4 * hi;
#define MLA_UV(kc, of) do { const bf16* w_ = wp + 16 * (kc); const u32x2 a0_ = *(const u32x2*)w_, a1_ = *(const u32x2*)(w_ + 8), b0_ = *(const u32x2*)(w_ + 32 * 128), b1_ = *(const u32x2*)(w_ + 32 * 128 + 8); \
        const bf16x8 A0_ = __builtin_bit_cast(bf16x8, (u32x4){a0_.x, a0_.y, a1_.x, a1_.y}), A1_ = __builtin_bit_cast(bf16x8, (u32x4){b0_.x, b0_.y, b1_.x, b1_.y}); \
        y0 = mfma32(A0_, of, y0); y1 = mfma32(A1_, of, y1); } while (0)
#define PK_LO(o) pack8(o[0], o[1], o[2], o[3], o[4], o[5], o[6], o[7])
#define PK_HI(o) pack8(o[8], o[9], o[10], o[11], o[12], o[13], o[14], o[15])
    MLA_UV(0, PK_LO(o0)); MLA_UV(1, PK_HI(o0)); MLA_UV(2, PK_LO(o1)); MLA_UV(3, PK_HI(o1));
    MLA_UV(4, PK_LO(o2)); MLA_UV(5, PK_HI(o2)); MLA_UV(6, PK_LO(o3)); MLA_UV(7, PK_HI(o3));
    const size_t obase = qrow * 1024 + 512 + head * 64 + 4 * hi;
#pragma unroll
    for (int g = 0; g < 4; ++g) {
        { const u32x2 gt = *(const u32x2*)(GATE + obase + 8 * g); const float o[4] = {y0[4 * g] * bflo(gt.x), y0[4 * g + 1] * bfhi(gt.x), y0[4 * g + 2] * bflo(gt.y), y0[4 * g + 3] * bfhi(gt.y)}; store_bf<4>(YCAT + obase + 8 * g, o); }
        { const u32x2 gt = *(const u32x2*)(GATE + obase + 32 + 8 * g); const float o[4] = {y1[4 * g] * bflo(gt.x), y1[4 * g + 1] * bfhi(gt.x), y1[4 * g + 2] * bflo(gt.y), y1[4 * g + 3] * bfhi(gt.y)}; store_bf<4>(YCAT + obase + 32 + 8 * g, o); }
    }
}
__device__ __forceinline__ void mla_sample_wave(const Params& p, const Ctx& c, int b, int sp) {
    unsigned char* ws = p.ws;
    const bf16* QP = (const bf16*)(ws + WS_QP); const bf16* KP = (const bf16*)(ws + WS_KP); float* PART = (float*)(ws + WS_PART);
    const int lane = c.lane, r32 = lane & 31, hi = lane >> 5, head = r32 & 7, tok = r32 >> 3;
    const size_t qrow = (size_t)MP + 4 * b + tok;
    bf16x8 qf[10];
#pragma unroll
    for (int s = 0; s < 8; ++s) qf[s] = *(const bf16x8*)(QP + qrow * 1280 + head * 128 + 16 * s + 8 * hi);
#pragma unroll
    for (int s = 0; s < 2; ++s) qf[8 + s] = *(const bf16x8*)(QP + qrow * 1280 + 1024 + head * 32 + 16 * s + 8 * hi);
    f32x16 o0 = {}, o1 = {}, o2 = {}, o3 = {}; float m = -1e30f, l = 0.f;
    LAS unsigned char* buf = c.lds + c.wave * (32 * KS);
    const int* pt = (const int*)p.in[IN_PT] + b * 128;
    const int ntile = (sp == 63) ? 9 : 8;
    const int vofs = (4 * hi + ((lane & 15) >> 2)) * KS + (((lane >> 4) & 1) * 16 + (lane & 3) * 4) * 2;
    for (int j = 0; j < ntile; ++j) {
        if (j < 8) {
            const int key0 = 256 * sp + 32 * j; const size_t prow = (size_t)pt[key0 >> 7] * 128 + (key0 & 127);
            const f32x4* sc = (const f32x4*)(p.in[IN_CCKV] + prow * 128);
            { const f32x4* sp_ = sc + lane; LAS unsigned char* dp_ = buf + (lane >> 5) * KS + (lane & 31) * 8;
#pragma unroll 4
              for (int i = 0; i < 16; ++i) { const f32x4 v = __builtin_nontemporal_load(sp_ + 64 * i); u32x2 w; w.x = pk2(v.x, v.y); w.y = pk2(v.z, v.w); *(LAS u32x2*)(dp_ + i * 2 * KS) = w; } }
            const float* sr = p.in[IN_CKR] + prow * 32;
#pragma unroll
            for (int i = 0; i < 2; ++i) { const int cmb = lane + 64 * i, row = cmb >> 2, i4 = cmb & 3; const f32x4 x1 = ldnt4(sr + row * 32 + 4 * i4), x2 = ldnt4(sr + row * 32 + 16 + 4 * i4);
                u32x4 w; w.x = pk2(x1.x, x2.x); w.y = pk2(x1.y, x2.y); w.z = pk2(x1.z, x2.z); w.w = pk2(x1.w, x2.w); *(LAS u32x4*)(buf + row * KS + 256 + i4 * 16) = w; }
        } else {
            { LAS u32x4* zp = (LAS u32x4*)buf + lane;
#pragma unroll
              for (int i = 0; i < 11; ++i) if (lane + 64 * i < 672) zp[64 * i] = (u32x4){0u, 0u, 0u, 0u}; }
            LDS_WAIT();
            { const bf16* src = KP + ((size_t)MP + 4 * b) * 160;
              const int r0 = lane / 20, c0 = lane - 20 * r0; *(LAS u32x4*)(buf + r0 * KS + c0 * 16) = *(const u32x4*)(src + lane * 8);
              if (lane < 16) { const int ch = 64 + lane, r1 = 3, c1 = ch - 60; *(LAS u32x4*)(buf + r1 * KS + c1 * 16) = *(const u32x4*)(src + ch * 8); } }
        }
        LDS_WAIT();
        f32x16 p0 = {};
        const LAS unsigned char* ka = buf + r32 * KS + hi * 16;
        { bf16x8 kf[10];
#pragma unroll
          for (int s = 0; s < 10; ++s) kf[s] = *(const LAS bf16x8*)(ka + s * 32);
          SCHED_FENCE();
#pragma unroll
          for (int s = 0; s < 10; ++s) p0 = mfma32(kf[s], qf[s], p0);
          SCHED_FENCE(); }
        if (j == 8) {
#pragma unroll
            for (int r = 0; r < 16; ++r) { const int key = crow(r, hi); if (key > tok) p0[r] = -INFINITY; }
        }
        float mx = max3f(p0[0], p0[1], p0[2]);
#pragma unroll
        for (int r = 3; r < 15; r += 2) mx = max3f(mx, p0[r], p0[r + 1]);
        mx = max2f(mx, p0[15]);
        mx = max2f(mx, xhalf(mx));
        if (__builtin_amdgcn_ballot_w64(mx > m) != 0ull) {
            const float mn = max2f(m, mx), alpha = EXP2(m - mn); m = mn;
            l *= alpha; o0 *= alpha; o1 *= alpha; o2 *= alpha; o3 *= alpha;
        }
        float rs = 0.f;
#pragma unroll
        for (int r = 0; r < 16; ++r) { p0[r] = EXP2(p0[r] - m); rs += p0[r]; }
        l += rs;
        const bf16x8 pf0 = pack8(p0[0], p0[1], p0[2], p0[3], p0[4], p0[5], p0[6], p0[7]), pf1 = pack8(p0[8], p0[9], p0[10], p0[11], p0[12], p0[13], p0[14], p0[15]);
        const LAS unsigned char* va = buf + vofs;
        MLA_PV(0, pf0); MLA_PV(1, pf1);
        LDS_WAIT();
    }
    l += xhalf(l);
    float* po = PART + ((size_t)b * 64 + sp) * PART_STRIDE + (unsigned)lane;
#pragma unroll
    for (int r = 0; r < 16; ++r) { po[r * 64] = o0[r]; po[1024 + r * 64] = o1[r]; po[2048 + r * 64] = o2[r]; po[3072 + r * 64] = o3[r]; }
    if (lane < 32) { po[4096] = m; po[4096 + 32] = l; }
}
__device__ __forceinline__ void phase_mla(const Params& p, const Ctx& c) {
    const bool sfirst = (c.cu & 1) != 0;
    if (sfirst) { for (int u = c.cu; u < 256; u += c.G) mla_sample_wave(p, c, u >> 3, (u & 7) * 8 + c.wave); __syncthreads(); }
    for (int i = c.cu; i < 512; i += c.G) { const int k = (i < 256) ? i : 767 - i;
        mla_prompt_unit(p, c, k & 7, 63 - (k >> 3)); }
    __syncthreads();
    if (!sfirst) { for (int u = c.cu; u < 256; u += c.G) mla_sample_wave(p, c, u >> 3, (u & 7) * 8 + c.wave); __syncthreads(); }
}
__device__ __forceinline__ void mla_combine_unit(const Params& p, const Ctx& c, int b) {
    unsigned char* ws = p.ws; const float* PART = (const float*)(ws + WS_PART) + (size_t)b * 64 * PART_STRIDE;
    const bf16* GATE = (const bf16*)(ws + WS_GATE); bf16* YCAT = (bf16*)(ws + WS_YCAT);
    LAS float* OS = (LAS float*)c.lds;
    const int tid = c.tid, q = tid & 31;
    float M = -1e30f;
#pragma unroll 16
    for (int s = 0; s < 64; ++s) M = fmaxf(M, PART[(size_t)s * PART_STRIDE + 4096 + q]);
    float L = 0.f, acc[8] = {0.f, 0.f, 0.f, 0.f, 0.f, 0.f, 0.f, 0.f};
#pragma unroll 1
    for (int s0 = 0; s0 < 64; s0 += 8) {
        float ms[8], ls[8], ov[8][8];
#pragma unroll
        for (int j = 0; j < 8; ++j) { const float* ps = PART + (size_t)(s0 + j) * PART_STRIDE; ms[j] = ps[4096 + q]; ls[j] = ps[4096 + 32 + q];
#pragma unroll
            for (int i = 0; i < 8; ++i) ov[j][i] = ps[tid + 512 * i]; }
#pragma unroll
        for (int j = 0; j < 8; ++j) { const float w = EXP2(ms[j] - M); L += w * ls[j];
#pragma unroll
            for (int i = 0; i < 8; ++i) acc[i] += w * ov[j][i]; }
    }
    const float inv = 1.f / L;
#pragma unroll
    for (int i = 0; i < 8; ++i) { const int e = tid + 512 * i, dbr = e >> 6, ln = e & 63; const int cc = 32 * (dbr >> 4) + crow(dbr & 15, ln >> 5); OS[q * 129 + cc] = acc[i] * inv; }
    __syncthreads();
    { const int qq = tid >> 4, v0 = (tid & 15) * 4, head = qq & 7, tok = qq >> 3; const float* wuv = p.in[IN_EWUV];
      float y[4] = {0.f, 0.f, 0.f, 0.f};
      for (int cc = 0; cc < 128; ++cc) { const float ov = OS[qq * 129 + cc]; const f32x4 w = *(const f32x4*)(wuv + ((size_t)cc * 8 + head) * 64 + v0); y[0] += ov * w.x; y[1] += ov * w.y; y[2] += ov * w.z; y[3] += ov * w.w; }
      const size_t ob = ((size_t)MP + 4 * b + tok) * 1024 + 512 + head * 64 + v0; const u32x2 gt = *(const u32x2*)(GATE + ob);
      const float o[4] = {y[0] * bflo(gt.x), y[1] * bfhi(gt.x), y[2] * bflo(gt.y), y[3] * bfhi(gt.y)}; store_bf<4>(YCAT + ob, o); }
    __syncthreads();
}
constexpr int XS = 528;
constexpr int XV = 576;
template <bool samp> __device__ __forceinline__ void xattn_unit(const Params& p, const Ctx& c, int layer, int b, int h, int qb, int dh_lo, int dh_hi) {
    unsigned char* ws = p.ws;
    const bf16* XQ = (const bf16*)(ws + WS_XQ); const bf16* XG = (const bf16*)(ws + WS_XG); bf16* XO = (bf16*)(ws + WS_XO);
    const int tid = c.tid, lane = c.lane, r32 = lane & 31, hi = lane >> 5;
    const size_t row = samp ? (size_t)MP + 4 * b + (r32 & 3) : (size_t)b * TP + qb * 256 + c.wave * 32 + r32;
    const bool active = !samp || c.wave == 0;
    const bf16* kb16 = (const bf16*)(ws + WS_MKV) + ((size_t)(layer * 2 + 0) * 2048 + (size_t)b * 256) * 1024 + h * 256;
    const bf16* vb16 = (const bf16*)(ws + WS_MKV) + ((size_t)(layer * 2 + 1) * 2048 + (size_t)b * 256) * 1024 + h * 256;
    const float* kf32 = p.in[IN_CMK] + ((size_t)(layer * 32 + b) * 256) * 1024 + h * 256;
    const float* vf32 = p.in[IN_CMV] + ((size_t)(layer * 32 + b) * 256) * 1024 + h * 256;
    u32x4 rgk[4], rgv[4];
    const unsigned voff = (unsigned)((tid >> 5) * 1024 + (tid & 31) * 8);
    const unsigned loff = (unsigned)((tid >> 5) * XS + (tid & 31) * 16), loffv = (unsigned)((tid >> 5) * XV + (tid & 31) * 16);
#define XA_LOAD(rg, p16, kt) do { if (!samp) { const bf16* t_ = (p16) + (size_t)(64 * (kt)) * 1024; \
            _Pragma("unroll") for (int i_ = 0; i_ < 4; ++i_) rg[i_] = *(const u32x4*)(t_ + (size_t)i_ * 16 * 1024 + voff); } } while (0)
#define XA_STORE(buf, lo_, st_, rg, p32, kt) do { if (!samp) { _Pragma("unroll") for (int i_ = 0; i_ < 4; ++i_) *(LAS u32x4*)((buf) + (lo_) + i_ * 16 * (st_)) = rg[i_]; } \
        else { const float* t_ = (p32) + (size_t)(64 * (kt)) * 1024 + voff;        \
            f32x4 a_[4], d_[4]; _Pragma("unroll") for (int i_ = 0; i_ < 4; ++i_) { const f32x4* s_ = (const f32x4*)(t_ + (size_t)i_ * 16 * 1024); a_[i_] = __builtin_nontemporal_load(s_); d_[i_] = __builtin_nontemporal_load(s_ + 1); } \
            _Pragma("unroll") for (int i_ = 0; i_ < 4; ++i_) *(LAS u32x4*)((buf) + (lo_) + i_ * 16 * (st_)) = (u32x4){pk2(a_[i_].x, a_[i_].y), pk2(a_[i_].z, a_[i_].w), pk2(d_[i_].x, d_[i_].y), pk2(d_[i_].z, d_[i_].w)}; } } while (0)
    LAS unsigned char* kbuf = c.lds; LAS unsigned char* vbuf = c.lds + 64 * XS;
    bf16x8 qf[16];
#pragma unroll
    for (int s = 0; s < 16; ++s) qf[s] = *(const bf16x8*)(XQ + row * 1024 + h * 256 + 16 * s + 8 * hi);
    const int vofs = (4 * hi + ((lane & 15) >> 2)) * XV + (((lane >> 4) & 1) * 16 + (lane & 3) * 4) * 2;
    const LAS unsigned char* ka = kbuf + r32 * XS + hi * 16;
#pragma unroll 1
    for (int dh = dh_lo; dh < dh_hi; ++dh) {
        f32x16 o0 = {}, o1 = {}, o2 = {}, o3 = {}; float m = -1e30f, l = 0.f;
        XA_LOAD(rgk, kb16, 0); XA_LOAD(rgv, vb16, 0);
#pragma unroll 1
        for (int kt = 0; kt < 4; ++kt) {
            __syncthreads();
            XA_STORE(kbuf, loff, XS, rgk, kf32, kt); XA_STORE(vbuf, loffv, XV, rgv, vf32, kt);
            __syncthreads();
            if (kt < 3) { XA_LOAD(rgk, kb16, kt + 1); XA_LOAD(rgv, vb16, kt + 1); }
            if (active) {
                f32x16 p0 = {}, p1 = {};
#pragma unroll
                for (int s2 = 0; s2 < 8; ++s2) { bf16x8 ka_[2], kb_[2];
#pragma unroll
                    for (int j = 0; j < 2; ++j) { ka_[j] = *(const LAS bf16x8*)(ka + (2 * s2 + j) * 32); kb_[j] = *(const LAS bf16x8*)(ka + 32 * XS + (2 * s2 + j) * 32); }
                    SCHED_FENCE();
#pragma unroll
                    for (int j = 0; j < 2; ++j) { p0 = mfma32(ka_[j], qf[2 * s2 + j], p0); p1 = mfma32(kb_[j], qf[2 * s2 + j], p1); }
                    SCHED_FENCE(); }
                float mx = fmaxf(p0[0], p1[0]);
#pragma unroll
                for (int r = 1; r < 16; ++r) mx = fmaxf(mx, fmaxf(p0[r], p1[r]));
                mx = fmaxf(mx, xhalf(mx));
                const float mn = fmaxf(m, mx), alpha = EXP2(m - mn); m = mn;
                float rs = 0.f;
#pragma unroll
                for (int r = 0; r < 16; ++r) { p0[r] = EXP2(p0[r] - mn); p1[r] = EXP2(p1[r] - mn); rs += p0[r] + p1[r]; }
                l = l * alpha + rs;
                o0 *= alpha; o1 *= alpha; o2 *= alpha; o3 *= alpha;
                const bf16x8 pf0 = pack8(p0[0], p0[1], p0[2], p0[3], p0[4], p0[5], p0[6], p0[7]), pf1 = pack8(p0[8], p0[9], p0[10], p0[11], p0[12], p0[13], p0[14], p0[15]);
                const bf16x8 pf2 = pack8(p1[0], p1[1], p1[2], p1[3], p1[4], p1[5], p1[6], p1[7]), pf3 = pack8(p1[8], p1[9], p1[10], p1[11], p1[12], p1[13], p1[14], p1[15]);
                const LAS unsigned char* va = vbuf + vofs + dh * 256;
#define XA_PV(ks, pf) do { const LAS unsigned char* v_ = va + (16 * (ks)) * XV; \
                    const s16x4 a0_ = tr_read(v_), a1_ = tr_read(v_ + 8 * XV), b0_ = tr_read(v_ + 64), b1_ = tr_read(v_ + 8 * XV + 64), c0_ = tr_read(v_ + 128), c1_ = tr_read(v_ + 8 * XV + 128), d0_ = tr_read(v_ + 192), d1_ = tr_read(v_ + 8 * XV + 192); \
                    SCHED_FENCE(); PRIO_HI(); \
                    o0 = mfma32(cat4(a0_, a1_), pf, o0); o1 = mfma32(cat4(b0_, b1_), pf, o1); o2 = mfma32(cat4(c0_, c1_), pf, o2); o3 = mfma32(cat4(d0_, d1_), pf, o3); \
                    PRIO_LO(); SCHED_FENCE(); } while (0)
                XA_PV(0, pf0); XA_PV(1, pf1); XA_PV(2, pf2); XA_PV(3, pf3);
            }
        }
        if (active && (!samp || r32 < 4)) {
            l += xhalf(l);
            const float inv = 1.f / l; const size_t ob = row * 1024 + h * 256 + dh * 128 + 4 * hi;
#define XA_OUT(db, o) do { _Pragma("unroll") for (int g = 0; g < 4; ++g) { const size_t a = ob + 32 * (db) + 8 * g; const u32x2 gt = *(const u32x2*)(XG + a); \
                const float ov[4] = {o[4 * g] * inv * bflo(gt.x), o[4 * g + 1] * inv * bfhi(gt.x), o[4 * g + 2] * inv * bflo(gt.y), o[4 * g + 3] * inv * bfhi(gt.y)}; store_bf<4>(XO + a, ov); } } while (0)
            XA_OUT(0, o0); XA_OUT(1, o1); XA_OUT(2, o2); XA_OUT(3, o3);
        }
    }
    __syncthreads();
}
__device__ __forceinline__ void xattn_prompt_unit(const Params& p, const Ctx& c, int layer, int b, int h, int qb) {
    unsigned char* ws = p.ws;
    const bf16* XQ = (const bf16*)(ws + WS_XQ); const bf16* XG = (const bf16*)(ws + WS_XG); bf16* XO = (bf16*)(ws + WS_XO);
    const int tid = c.tid, lane = c.lane, r32 = lane & 31, hi = lane >> 5;
    const size_t row = (size_t)b * TP + qb * 256 + c.wave * 32 + r32;
    const bf16* kb16 = (const bf16*)(ws + WS_MKV) + ((size_t)(layer * 2 + 0) * 2048 + (size_t)b * 256) * 1024 + h * 256;
    const bf16* vb16 = (const bf16*)(ws + WS_MKV) + ((size_t)(layer * 2 + 1) * 2048 + (size_t)b * 256) * 1024 + h * 256;
    u32x4 rg[4];
    const unsigned voff = (unsigned)((tid >> 5) * 1024 + (tid & 31) * 8);
    const unsigned loff = (unsigned)((tid >> 5) * XS + (tid & 31) * 16), loffv = (unsigned)((tid >> 5) * XV + (tid & 31) * 16);
#define XP_LOAD(p16, kt) do { const bf16* t_ = (p16) + (size_t)(64 * (kt)) * 1024; _Pragma("unroll") for (int i_ = 0; i_ < 4; ++i_) rg[i_] = *(const u32x4*)(t_ + (size_t)i_ * 16 * 1024 + voff); } while (0)
#define XP_STORE(buf, lo_, st_) do { _Pragma("unroll") for (int i_ = 0; i_ < 4; ++i_) *(LAS u32x4*)((buf) + (lo_) + i_ * 16 * (st_)) = rg[i_]; } while (0)
    LAS unsigned char* kbuf = c.lds; LAS unsigned char* vbuf = c.lds + 64 * XS;
    bf16x8 pf[16]; float mk0 = 0.f, mk1 = 0.f, mk2 = 0.f, m = -1e30f, l = 0.f;
    XP_LOAD(kb16, 0);
    {
        bf16x8 qf[16];
#pragma unroll
        for (int s = 0; s < 16; ++s) qf[s] = *(const bf16x8*)(XQ + row * 1024 + h * 256 + 16 * s + 8 * hi);
        const LAS unsigned char* ka = kbuf + r32 * XS + hi * 16;
#pragma unroll
        for (int kt = 0; kt < 4; ++kt) {
            __syncthreads();
            XP_STORE(kbuf, loff, XS);
            __syncthreads();
            if (kt < 3) XP_LOAD(kb16, kt + 1); else XP_LOAD(vb16, 0);
            f32x16 p0 = {}, p1 = {};
#pragma unroll
            for (int s2 = 0; s2 < 8; ++s2) { bf16x8 ka_[2], kb_[2];
#pragma unroll
                for (int j = 0; j < 2; ++j) { ka_[j] = *(const LAS bf16x8*)(ka + (2 * s2 + j) * 32); kb_[j] = *(const LAS bf16x8*)(ka + 32 * XS + (2 * s2 + j) * 32); }
                SCHED_FENCE(); PRIO_HI();
#pragma unroll
                for (int j = 0; j < 2; ++j) { p0 = mfma32(ka_[j], qf[2 * s2 + j], p0); p1 = mfma32(kb_[j], qf[2 * s2 + j], p1); }
                PRIO_LO(); SCHED_FENCE(); }
            float mx = fmaxf(p0[0], p1[0]);
#pragma unroll
            for (int r = 1; r < 16; ++r) mx = fmaxf(mx, fmaxf(p0[r], p1[r]));
            mx = fmaxf(mx, xhalf(mx));
            const float mn = fmaxf(m, mx); l *= EXP2(m - mn); m = mn;
            if (kt == 0) mk0 = mn; else if (kt == 1) mk1 = mn; else if (kt == 2) mk2 = mn;
            float rs = 0.f;
#pragma unroll
            for (int r = 0; r < 16; ++r) { p0[r] = EXP2(p0[r] - mn); p1[r] = EXP2(p1[r] - mn); rs += p0[r] + p1[r]; }
            l += rs;
            pf[4 * kt + 0] = pack8(p0[0], p0[1], p0[2], p0[3], p0[4], p0[5], p0[6], p0[7]); pf[4 * kt + 1] = pack8(p0[8], p0[9], p0[10], p0[11], p0[12], p0[13], p0[14], p0[15]);
            pf[4 * kt + 2] = pack8(p1[0], p1[1], p1[2], p1[3], p1[4], p1[5], p1[6], p1[7]); pf[4 * kt + 3] = pack8(p1[8], p1[9], p1[10], p1[11], p1[12], p1[13], p1[14], p1[15]);
        }
    }
    l += xhalf(l);
    { const float inv = 1.f / l;
#pragma unroll
      for (int i = 0; i < 16; ++i) { const float f = (i < 4 ? EXP2(mk0 - m) : i < 8 ? EXP2(mk1 - m) : i < 12 ? EXP2(mk2 - m) : 1.f) * inv; u32x4 w = __builtin_bit_cast(u32x4, pf[i]);
          w.x = pk2(bflo(w.x) * f, bfhi(w.x) * f); w.y = pk2(bflo(w.y) * f, bfhi(w.y) * f); w.z = pk2(bflo(w.z) * f, bfhi(w.z) * f); w.w = pk2(bflo(w.w) * f, bfhi(w.w) * f); pf[i] = __builtin_bit_cast(bf16x8, w); } }
    const int vofs = (4 * hi + ((lane & 15) >> 2)) * XV + (((lane >> 4) & 1) * 16 + (lane & 3) * 4) * 2;
#pragma unroll
    for (int dh = 0; dh < 2; ++dh) {
        f32x16 o0 = {}, o1 = {}, o2 = {}, o3 = {};
#pragma unroll
        for (int vt = 0; vt < 4; ++vt) {
            __syncthreads();
            XP_STORE(vbuf, loffv, XV);
            __syncthreads();
            if (vt < 3) XP_LOAD(vb16, vt + 1); else if (dh == 0) XP_LOAD(vb16, 0);
            const LAS unsigned char* va = vbuf + vofs + dh * 256;
            XA_PV(0, pf[4 * vt + 0]); XA_PV(1, pf[4 * vt + 1]); XA_PV(2, pf[4 * vt + 2]); XA_PV(3, pf[4 * vt + 3]);
        }
        const float inv = 1.f; const size_t ob = row * 1024 + h * 256 + dh * 128 + 4 * hi;
        XA_OUT(0, o0); XA_OUT(1, o1); XA_OUT(2, o2); XA_OUT(3, o3);
    }
    __syncthreads();
}
__device__ __forceinline__ void phase_xattn(const Params& p, const Ctx& c, int layer) {
    const int vcu = (c.G % 8 == 0) ? (c.cu & 7) * (c.G >> 3) + (c.cu >> 3) : c.cu;
    for (int u = vcu; u < 256; u += c.G) xattn_prompt_unit(p, c, layer, u >> 5, (u >> 3) & 3, u & 7);
    for (int s = vcu; s < 256; s += c.G) xattn_unit<true>(p, c, layer, s >> 3, (s >> 1) & 3, 0, s & 1, (s & 1) + 1);
}
__device__ __forceinline__ void phase_conv4(const Params& p, const Ctx& c) {
    unsigned char* ws = p.ws; const bf16* XBC = (const bf16*)(ws + WS_XBC); bf16* XBCC = (bf16*)(ws + WS_XBCC);
    const float* cw = p.in[IN_OCW]; const float* cb = p.in[IN_OCB];
    const int gt = c.gw * 64 + c.lane, NGT = c.NGW * 64;
    for (int idx = gt; idx < (MP / 8) * 384; idx += NGT) {
        const int rg = idx / 384, c8 = idx % 384, row0 = rg * 8, t0 = row0 & (TP - 1), ch = c8 * 8;
        float w[4][8], bias[8];
#pragma unroll
        for (int k = 0; k < 4; ++k) { const f32x4 a = *(const f32x4*)(cw + k * 3072 + ch), d = *(const f32x4*)(cw + k * 3072 + ch + 4); w[k][0] = a.x; w[k][1] = a.y; w[k][2] = a.z; w[k][3] = a.w; w[k][4] = d.x; w[k][5] = d.y; w[k][6] = d.z; w[k][7] = d.w; }
        { const f32x4 a = *(const f32x4*)(cb + ch), d = *(const f32x4*)(cb + ch + 4); bias[0] = a.x; bias[1] = a.y; bias[2] = a.z; bias[3] = a.w; bias[4] = d.x; bias[5] = d.y; bias[6] = d.z; bias[7] = d.w; }
        u32x4 x[11];
#pragma unroll
        for (int i = 0; i < 11; ++i) { x[i] = (u32x4){0u, 0u, 0u, 0u}; if (t0 + i - 3 >= 0) x[i] = *(const u32x4*)(XBC + (size_t)(row0 + i - 3) * 3072 + ch); }
#pragma unroll
        for (int t = 0; t < 8; ++t) { float a[8];
#pragma unroll
            for (int e = 0; e < 8; ++e) a[e] = bias[e];
#pragma unroll
            for (int k = 0; k < 4; ++k) { const u32x4 v = x[t + k]; a[0] = fmaf(w[k][0], bflo(v.x), a[0]); a[1] = fmaf(w[k][1], bfhi(v.x), a[1]); a[2] = fmaf(w[k][2], bflo(v.y), a[2]); a[3] = fmaf(w[k][3], bfhi(v.y), a[3]);
                a[4] = fmaf(w[k][4], bflo(v.z), a[4]); a[5] = fmaf(w[k][5], bfhi(v.z), a[5]); a[6] = fmaf(w[k][6], bflo(v.w), a[6]); a[7] = fmaf(w[k][7], bfhi(v.w), a[7]); }
#pragma unroll
            for (int e = 0; e < 8; ++e) a[e] = siluf_(a[e]);
            store_bf<8>(XBCC + (size_t)(row0 + t) * 3072 + ch, a); }
        if (t0 == TP - 8) { float* o = p.out + O_CCP + (size_t)(row0 >> 11) * 3 * 3072 + ch;
#pragma unroll
            for (int i = 0; i < 3; ++i) { const u32x4 v = x[8 + i]; *(f32x4*)(o + i * 3072) = (f32x4){bflo(v.x), bfhi(v.x), bflo(v.y), bfhi(v.y)}; *(f32x4*)(o + i * 3072 + 4) = (f32x4){bflo(v.z), bfhi(v.z), bflo(v.w), bfhi(v.w)}; } }
    }
    for (int idx = gt; idx < NBS * 384; idx += NGT) {
        const int b = idx / 384, c8 = idx % 384, ch = c8 * 8; const size_t row0 = (size_t)MP + 4 * b;
        float xe[7][8];
#pragma unroll
        for (int i = 0; i < 3; ++i) { const float* s = p.in[IN_SCC] + ((size_t)b * 3 + i) * 3072 + ch; const f32x4 a = *(const f32x4*)s, d = *(const f32x4*)(s + 4); xe[i][0] = a.x; xe[i][1] = a.y; xe[i][2] = a.z; xe[i][3] = a.w; xe[i][4] = d.x; xe[i][5] = d.y; xe[i][6] = d.z; xe[i][7] = d.w; }
#pragma unroll
        for (int i = 0; i < 4; ++i) { const u32x4 v = *(const u32x4*)(XBC + (row0 + i) * 3072 + ch); xe[3 + i][0] = bflo(v.x); xe[3 + i][1] = bfhi(v.x); xe[3 + i][2] = bflo(v.y); xe[3 + i][3] = bfhi(v.y); xe[3 + i][4] = bflo(v.z); xe[3 + i][5] = bfhi(v.z); xe[3 + i][6] = bflo(v.w); xe[3 + i][7] = bfhi(v.w); }
#pragma unroll
        for (int t = 0; t < 4; ++t) { float a[8];
#pragma unroll
            for (int e = 0; e < 8; ++e) { float s = cb[ch + e];
#pragma unroll
                for (int k = 0; k < 4; ++k) s = fmaf(cw[k * 3072 + ch + e], xe[t + k][e], s);
                a[e] = siluf_(s); }
            store_bf<8>(XBCC + (row0 + t) * 3072 + ch, a); }
        float* o = p.out + O_CCS + (size_t)b * 3 * 3072 + ch;
#pragma unroll
        for (int i = 0; i < 3; ++i) { *(f32x4*)(o + i * 3072) = (f32x4){xe[4 + i][0], xe[4 + i][1], xe[4 + i][2], xe[4 + i][3]}; *(f32x4*)(o + i * 3072 + 4) = (f32x4){xe[4 + i][4], xe[4 + i][5], xe[4 + i][6], xe[4 + i][7]}; }
    }
}

constexpr int BSS = 272, XSS = 144;
constexpr int L_BS = 0, L_CS = 128 * 256, L_XS = L_CS + 128 * BSS, L_XD = L_XS + 128 * XSS, L_SB = L_XD + 128 * XSS, L_CUM = L_SB + 64 * BSS, L_DTV = L_CUM + 512, L_YT = L_DTV + 512, L_SSD_END = L_YT + 128 * XSS;
static_assert(L_SSD_END <= MISC_OFF, "ssd lds");
__device__ __forceinline__ int bs_f(int r) { return ((r & 3) << 2) | ((r >> 2) & 3); }
__device__ __forceinline__ void ssd_prompt_unit(const Params& p, const Ctx& c, int b, int hd) {
    unsigned char* ws = p.ws;
    const bf16* XB = (const bf16*)(ws + WS_XBCC); const bf16* ZS = (const bf16*)(ws + WS_ZS); const float* DT = (const float*)(ws + WS_DT); bf16* YZ = (bf16*)(ws + WS_YZ);
    const int tid = c.tid, lane = c.lane, r32 = lane & 31, hi = lane >> 5, w = c.wave, pb = w >> 2, tb = pb ? 3 - (w & 3) : (w & 3), g = hd >> 3;
    const float a_h = -__expf(p.in[IN_OALOG][hd]), d_h = p.in[IN_OD][hd];
    LAS unsigned char* L = c.lds;
    LAS float* CUM = (LAS float*)(L + L_CUM); LAS float* DTV = (LAS float*)(L + L_DTV);
    f32x16 st = {};
    const int trofs = ((lane & 15) >> 2);
    const int trcol = (((lane >> 4) & 1) * 16 + (lane & 3) * 4) * 2;
    u32x4 rb[4], rc[4], rx[2]; float d0 = 0.f, d1 = 0.f;
    const bf16* bbase = XB + (size_t)b * TP * 3072 + 2048 + g * 128; const bf16* xbase = XB + (size_t)b * TP * 3072 + hd * 64;
    const bf16* zbase = ZS + (size_t)b * TP * 2048 + hd * 64; const float* dbase = DT + (size_t)b * TP * 32 + hd;
    const unsigned bo = (unsigned)((tid >> 4) * 3072 + (tid & 15) * 8), xo = (unsigned)((tid >> 3) * 3072 + (tid & 7) * 8), zo = (unsigned)((tid >> 3) * 2048 + (tid & 7) * 8), dof = (unsigned)(2 * lane * 32);
#define SSD_LOAD(ck_) do { const bf16* bb_ = bbase + (size_t)(128 * (ck_)) * 3072; const bf16* xb_ = xbase + (size_t)(128 * (ck_)) * 3072; \
        _Pragma("unroll") for (int i_ = 0; i_ < 4; ++i_) { rb[i_] = *(const u32x4*)(bb_ + (size_t)i_ * 32 * 3072 + bo); rc[i_] = *(const u32x4*)(bb_ + (size_t)i_ * 32 * 3072 + 512 + bo); } \
        _Pragma("unroll") for (int i_ = 0; i_ < 2; ++i_) rx[i_] = *(const u32x4*)(xb_ + (size_t)i_ * 64 * 3072 + xo); \
        if (w == 0) { const float* db_ = dbase + (size_t)(128 * (ck_)) * 32; d0 = db_[dof]; d1 = db_[dof + 32]; } } while (0)
    SSD_LOAD(0);
    const int lbc = (tid >> 4) * BSS + (tid & 15) * 16, lx = (tid >> 3) * XSS + (tid & 7) * 16;
    const int lbs = (tid >> 4) * 256 + 16 * ((tid & 15) ^ bs_f(tid >> 4));
    const int fs_row = bs_f(r32);
    const int f_lo = (trofs << 2) | (2 * hi), f_hi = (trofs << 2) | (2 * hi + 1);
#pragma unroll 1
    for (int ck = 0; ck < 16; ++ck) {
        asm volatile("; SSD_CHUNK_BEGIN");
        const size_t row0 = (size_t)b * TP + 128 * ck;
        __syncthreads();
        if (w == 0) { const float v0 = a_h * LOG2E * d0, v1 = a_h * LOG2E * d1; float s = v0 + v1;
#pragma unroll
            for (int o = 1; o < 64; o <<= 1) { const float t = __shfl_up(s, o); if (lane >= o) s += t; }
            CUM[2 * lane] = s - v1; CUM[2 * lane + 1] = s; DTV[2 * lane] = (s - v1) - __builtin_amdgcn_logf(d0); DTV[2 * lane + 1] = s - __builtin_amdgcn_logf(d1); }
#pragma unroll
        for (int i = 0; i < 4; ++i) { *(LAS u32x4*)(L + L_BS + lbs + i * 32 * 256) = rb[i]; *(LAS u32x4*)(L + L_CS + lbc + i * 32 * BSS) = rc[i]; }
#pragma unroll
        for (int i = 0; i < 2; ++i) *(LAS u32x4*)(L + L_XS + lx + i * 64 * XSS) = rx[i];
#pragma unroll
        for (int r = 0; r < 16; ++r) *(LAS unsigned short*)(L + L_SB + (32 * pb + crow(r, hi)) * BSS + (32 * tb + r32) * 2) = (unsigned short)f2bf(st[r]);
        __syncthreads();
        const float cum_last = CUM[127];
#pragma unroll
        for (int i = 0; i < 2; ++i) { const int row = (tid >> 3) + 64 * i; const u32x4 v = rx[i]; const float te = EXP2(cum_last - DTV[row]);
            *(LAS u32x4*)(L + L_XD + lx + i * 64 * XSS) = (u32x4){pk2(bflo(v.x) * te, bfhi(v.x) * te), pk2(bflo(v.y) * te, bfhi(v.y) * te), pk2(bflo(v.z) * te, bfhi(v.z) * te), pk2(bflo(v.w) * te, bfhi(v.w) * te)}; }
        if (ck < 15) SSD_LOAD(ck + 1);
        const int t = 32 * tb + r32; const float cum_t = CUM[t];
        bf16x8 cf[8];
#pragma unroll
        for (int kn = 0; kn < 8; ++kn) cf[kn] = *(const LAS bf16x8*)(L + L_CS + t * BSS + (16 * kn + 8 * hi) * 2);
        SCHED_FENCE();
        f32x16 y = {};
        { bf16x8 sf[8];
#pragma unroll
          for (int kn = 0; kn < 8; ++kn) sf[kn] = *(const LAS bf16x8*)(L + L_SB + (32 * pb + r32) * BSS + (16 * kn + 8 * hi) * 2);
          SCHED_FENCE();
#pragma unroll
          for (int kn = 0; kn < 8; ++kn) y = mfma32(sf[kn], cf[kn], y);
          SCHED_FENCE(); }
        y *= EXP2(cum_t);
#define SSD_CB(xd_, sb_) do { xd_ = (f32x16){}; \
            _Pragma("unroll") for (int k4 = 0; k4 < 2; ++k4) { bf16x8 bfr[4]; \
                _Pragma("unroll") for (int kn = 0; kn < 4; ++kn) bfr[kn] = *(const LAS bf16x8*)(L + L_BS + (32 * (sb_) + r32) * 256 + 16 * ((2 * (4 * k4 + kn) + hi) ^ fs_row)); \
                SCHED_FENCE(); \
                _Pragma("unroll") for (int kn = 0; kn < 4; ++kn) xd_ = mfma32(bfr[kn], cf[4 * k4 + kn], xd_); \
                SCHED_FENCE(); } } while (0)
        f32x16 x; SSD_CB(x, 0);
#pragma unroll 1
        for (int sb = 0; sb <= tb; ++sb) {
            f32x16 xn; { const int sn = sb < tb ? sb + 1 : tb; SSD_CB(xn, sn); }
            const LAS unsigned char* xa = L + L_XS + (32 * sb + 4 * hi + trofs) * XSS + pb * 64 + trcol;
            const s16x4 t0 = tr_read(xa), t1 = tr_read(xa + 8 * XSS), t2 = tr_read(xa + 16 * XSS), t3 = tr_read(xa + 24 * XSS);
            { f32x4 ev[4];
#pragma unroll
              for (int g4 = 0; g4 < 4; ++g4) ev[g4] = *(const LAS f32x4*)(DTV + 32 * sb + 8 * g4 + 4 * hi);
              if (sb == tb) {
#pragma unroll
                for (int r = 0; r < 16; ++r) { const float wv = x[r] * EXP2(cum_t - ev[r >> 2][r & 3]); x[r] = (crow(r, hi) <= r32) ? wv : 0.f; }
              } else {
#pragma unroll
                for (int r = 0; r < 16; ++r) x[r] *= EXP2(cum_t - ev[r >> 2][r & 3]);
              } }
            const bf16x8 wf0 = pack8(x[0], x[1], x[2], x[3], x[4], x[5], x[6], x[7]), wf1 = pack8(x[8], x[9], x[10], x[11], x[12], x[13], x[14], x[15]);
            y = mfma32(cat4(t0, t1), wf0, y); y = mfma32(cat4(t2, t3), wf1, y);
            x = xn;
        }
        {
#pragma unroll
            for (int g4 = 0; g4 < 4; ++g4) { const int p0 = 32 * pb + 8 * g4 + 4 * hi; const u32x2 xv = *(const LAS u32x2*)(L + L_XS + t * XSS + p0 * 2);
                u32x2 o; o.x = pk2(y[4 * g4] + d_h * bflo(xv.x), y[4 * g4 + 1] + d_h * bfhi(xv.x)); o.y = pk2(y[4 * g4 + 2] + d_h * bflo(xv.y), y[4 * g4 + 3] + d_h * bfhi(xv.y));
                *(LAS u32x2*)(L + L_YT + t * XSS + p0 * 2) = o; }
        }
        asm volatile("s_waitcnt lgkmcnt(0)\n\ts_barrier" ::: "memory");
        const bf16* zb_ = zbase + (size_t)(128 * ck) * 2048; const u32x4 zc0 = *(const u32x4*)(zb_ + zo), zc1 = *(const u32x4*)(zb_ + (size_t)64 * 2048 + zo);
        st *= EXP2(cum_last);
        { const LAS unsigned char* xa = L + L_XD + (8 * hi + trofs) * XSS + pb * 64 + trcol;
          const int bch = 4 * tb + 2 * ((lane >> 4) & 1) + ((lane & 3) >> 1), bsub = 8 * (lane & 1);
          const LAS unsigned char* ba_lo = L + L_BS + (8 * hi + trofs) * 256 + 16 * (bch ^ f_lo) + bsub; const LAS unsigned char* ba_hi = L + L_BS + (8 * hi + trofs + 4) * 256 + 16 * (bch ^ f_hi) + bsub;
#pragma unroll
          for (int k4 = 0; k4 < 2; ++k4) { s16x4 ta[4], tb2[4], tc[4], td[4];
#pragma unroll
              for (int j = 0; j < 4; ++j) { const int ks = 4 * k4 + j; ta[j] = tr_read(xa + (16 * ks) * XSS); tb2[j] = tr_read(xa + (16 * ks + 4) * XSS); tc[j] = tr_read(ba_lo + (16 * ks) * 256); td[j] = tr_read(ba_hi + (16 * ks) * 256); }
              SCHED_FENCE();
#pragma unroll
              for (int j = 0; j < 4; ++j) st = mfma32(cat4(ta[j], tb2[j]), cat4(tc[j], td[j]), st);
              SCHED_FENCE(); } }
#pragma unroll
        for (int i = 0; i < 2; ++i) { const int row = (tid >> 3) + 64 * i; const u32x4 yv = *(const LAS u32x4*)(L + L_YT + lx + i * 64 * XSS); const size_t ga = (row0 + row) * 2048 + hd * 64 + (tid & 7) * 8; const u32x4 zv = i ? zc1 : zc0;
            const float o[8] = {bflo(yv.x) * bflo(zv.x), bfhi(yv.x) * bfhi(zv.x), bflo(yv.y) * bflo(zv.y), bfhi(yv.y) * bfhi(zv.y), bflo(yv.z) * bflo(zv.z), bfhi(yv.z) * bfhi(zv.z), bflo(yv.w) * bflo(zv.w), bfhi(yv.w) * bfhi(zv.w)};
            store_bf<8>(YZ + ga, o);
            { float ss = 0.f;
#pragma unroll
              for (int e8 = 0; e8 < 8; ++e8) ss += o[e8] * o[e8];
              ss += dpp_mov<0xB1>(ss); ss += dpp_mov<0x4E>(ss); ss += dpp_mov<0x141>(ss);
              if ((tid & 7) == 0) atomicAdd((float*)(ws + WS_GS) + (row0 + row) * 4 + g, ss); } }
        asm volatile("; SSD_CHUNK_END");
    }
    { unsigned so_off = (unsigned)((32 * pb + 4 * hi) * 128 + 32 * tb + r32); asm volatile("" : "+v"(so_off));
      float* so = p.out + O_SSMP + ((size_t)(b * 32 + hd) * 64) * 128 + so_off;
#pragma unroll
      for (int r = 0; r < 16; ++r) so[((r & 3) + 8 * (r >> 2)) * 128] = st[r]; }
    __syncthreads();
}
__device__ __forceinline__ void ssd_sample_unit(const Params& p, const Ctx& c, int b, int hd, const f32x4 (&sin)[4]) {
    unsigned char* ws = p.ws;
    const bf16* XB = (const bf16*)(ws + WS_XBCC); const bf16* ZS = (const bf16*)(ws + WS_ZS); const float* DT = (const float*)(ws + WS_DT); bf16* YZ = (bf16*)(ws + WS_YZ);
    const int tid = c.tid, pp = tid >> 3, n0 = (tid & 7) * 16, g = hd >> 3;
    const float a_h = -__expf(p.in[IN_OALOG][hd]), d_h = p.in[IN_OD][hd];
    float st[16];
#pragma unroll
    for (int i = 0; i < 4; ++i) { const f32x4 v = sin[i]; st[4 * i] = v.x; st[4 * i + 1] = v.y; st[4 * i + 2] = v.z; st[4 * i + 3] = v.w; }
#pragma unroll
    for (int t = 0; t < 4; ++t) { const size_t row = (size_t)MP + 4 * b + t; const float dt = DT[row * 32 + hd], dA = __expf(dt * a_h);
        const float xv = bf2f(XB[row * 3072 + hd * 64 + pp]);
        const u32x4 b0 = *(const u32x4*)(XB + row * 3072 + 2048 + g * 128 + n0), b1 = *(const u32x4*)(XB + row * 3072 + 2048 + g * 128 + n0 + 8);
        const u32x4 c0 = *(const u32x4*)(XB + row * 3072 + 2560 + g * 128 + n0), c1 = *(const u32x4*)(XB + row * 3072 + 2560 + g * 128 + n0 + 8);
        const float bv[16] = {bflo(b0.x), bfhi(b0.x), bflo(b0.y), bfhi(b0.y), bflo(b0.z), bfhi(b0.z), bflo(b0.w), bfhi(b0.w), bflo(b1.x), bfhi(b1.x), bflo(b1.y), bfhi(b1.y), bflo(b1.z), bfhi(b1.z), bflo(b1.w), bfhi(b1.w)};
        const float cv[16] = {bflo(c0.x), bfhi(c0.x), bflo(c0.y), bfhi(c0.y), bflo(c0.z), bfhi(c0.z), bflo(c0.w), bfhi(c0.w), bflo(c1.x), bfhi(c1.x), bflo(c1.y), bfhi(c1.y), bflo(c1.z), bfhi(c1.z), bflo(c1.w), bfhi(c1.w)};
        const float xdt = xv * dt; float y = 0.f;
#pragma unroll
        for (int i = 0; i < 16; ++i) { st[i] = fmaf(st[i], dA, xdt * bv[i]); y = fmaf(st[i], cv[i], y); }
        y += __shfl_xor(y, 1); y += __shfl_xor(y, 2); y += __shfl_xor(y, 4);
        if ((tid & 7) == 0) { const float z = bf2f(ZS[row * 2048 + hd * 64 + pp]); YZ[row * 2048 + hd * 64 + pp] = (bf16)f2bf((y + d_h * xv) * z); }
    }
    float* so = p.out + O_SSMS + (((size_t)b * 32 + hd) * 64 + pp) * 128 + n0;
#pragma unroll
    for (int i = 0; i < 4; ++i) __builtin_nontemporal_store((f32x4){st[4 * i], st[4 * i + 1], st[4 * i + 2], st[4 * i + 3]}, (f32x4*)(so + 4 * i));
}
__device__ __forceinline__ void phase_ssd(const Params& p, const Ctx& c) {
#ifndef REPSUB
#define REPSUB 0
#endif
#pragma unroll 1
    for (int rep = 0; rep < 1 + (REPSUB & 1); ++rep)
    { const int vcu = (c.G % 8 == 0) ? (c.cu & 7) * (c.G >> 3) + (c.cu >> 3) : c.cu;
      for (int u = vcu; u < 256; u += c.G) ssd_prompt_unit(p, c, u >> 5, u & 31); }
#pragma unroll 1
    for (int rep = 0; rep < 1 + ((REPSUB >> 1) & 1); ++rep)
    {
        const int tid = c.tid; const float* sbase = p.in[IN_SSM] + (size_t)(tid >> 3) * 128 + (tid & 7) * 16;
        f32x4 nx[4];
        if (c.cu < 1024) {
#pragma unroll
            for (int i = 0; i < 4; ++i) nx[i] = ldnt4(sbase + (size_t)c.cu * 64 * 128 + 4 * i); }
#pragma unroll 1
        for (int u = c.cu; u < 1024; u += c.G) {
            f32x4 cur[4];
#pragma unroll
            for (int i = 0; i < 4; ++i) cur[i] = nx[i];
            if (u + c.G < 1024) {
#pragma unroll
                for (int i = 0; i < 4; ++i) nx[i] = ldnt4(sbase + (size_t)(u + c.G) * 64 * 128 + 4 * i); }
            ssd_sample_unit(p, c, u >> 5, u & 31, cur);
        }
    }
}
__device__ __forceinline__ void phase_gnorm(const Params& p, const Ctx& c) {
    unsigned char* ws = p.ws; const bf16* YZ = (const bf16*)(ws + WS_YZ); bf16* YN = (bf16*)(ws + WS_YN); const float* nw = p.in[IN_ONORM];
    for (int r = c.gw; r < MT; r += c.NGW) {
#pragma unroll
        for (int j = 0; j < 4; ++j) { const int e0 = 8 * (c.lane + 64 * j); const u32x4 v = *(const u32x4*)(YZ + (size_t)r * 2048 + e0);
            const float x[8] = {bflo(v.x), bfhi(v.x), bflo(v.y), bfhi(v.y), bflo(v.z), bfhi(v.z), bflo(v.w), bfhi(v.w)};
            float s = 0.f;
#pragma unroll
            for (int e = 0; e < 8; ++e) s += x[e] * x[e];
            const float rr = rsqrtf(wave_sum(s) * (1.f / 512.f) + EPS); const f32x4 w0 = *(const f32x4*)(nw + e0), w1 = *(const f32x4*)(nw + e0 + 4);
            const float o[8] = {x[0] * rr * w0.x, x[1] * rr * w0.y, x[2] * rr * w0.z, x[3] * rr * w0.w, x[4] * rr * w1.x, x[5] * rr * w1.y, x[6] * rr * w1.z, x[7] * rr * w1.w};
            store_bf<8>(YN + (size_t)r * 2048 + e0, o); }
    }
}
constexpr int NPHASE = 22;
template <class F> __device__ __forceinline__ void run_gemm(const Ctx& c, const bf16* A, const bf16* Bt, int M, int N, int K, int cu_eff, const F& f, const float* rs = nullptr) {
    pg8::Gemm g{A, Bt, M, N, K}; pg8::StaticOrder S; S.init(M, N, c.G, cu_eff);
    Epi8<F> E{f, rs};
    pg8::gemm_phase<Epi8<F>, pg8::StaticOrder, true, true>((PG8_LAS unsigned char*)c.lds, g, S, E, c.tid);
}
__global__ void __launch_bounds__(512, 2) mega_fwd(Params p) {
    extern __shared__ __attribute__((aligned(16))) unsigned char lds_raw[];
    LAS unsigned char* const lds0 = (LAS unsigned char*)lds_raw;
    const int wave0 = __builtin_amdgcn_readfirstlane((int)threadIdx.x >> 6);
#define MKCTX() Ctx c; { int l_; asm volatile("v_mbcnt_lo_u32_b32 %0, -1, 0\n\tv_mbcnt_hi_u32_b32 %0, -1, %0" : "=v"(l_)); c.lds = lds0; c.lane = l_; c.wave = wave0; c.tid = wave0 * 64 + l_; \
        c.G = gridDim.x; c.cu = blockIdx.x; c.gw = c.cu * 8 + c.wave; c.NGW = c.G * 8; }
    unsigned char* ws = p.ws;
    volatile LAS unsigned* MISC = (volatile LAS unsigned*)(lds0 + MISC_OFF);
    { MKCTX(); for (int u = c.tid; u < (LDS_BYTES - RING_BYTES) / 4; u += 512) ((LAS unsigned*)(lds0 + RING_BYTES))[u] = 0u; }
    __syncthreads();
    const int lo = p.ph_lo, hi = p.ph_hi;
    const bool multi = (hi - lo) > 1;
    XcdBarrier bar; bar.bar = (unsigned*)(ws + WS_CTL) + CW_BAR; bar.x = 0; bar.st = nullptr;
    if (multi) { MKCTX(); bar = xcd_barrier_post((unsigned*)(ws + WS_CTL) + CW_BAR, MISC + 8, c.tid); }
#ifndef PHMASK
#define PHMASK 0x3fffff
#endif
#define IN(k) ((((PHMASK) >> (k)) & 1) && lo <= (k) && (k) < hi)
#ifndef REPMASK
#define REPMASK 0
#endif
#define NREP(k) (1 + (((REPMASK) >> (k)) & 1))
#define REPBAR(r) do { if (r) { MKCTX(); xcd_barrier(bar, c.tid); } } while (0)
#define SEAM(k) do { if (IN(k) && IN((k) + 1)) { MKCTX(); xcd_barrier(bar, c.tid); } } while (0)
    bf16* XRA = (bf16*)(ws + WS_XR); const float* RS = (const float*)(ws + WS_RS); bf16* YB = (bf16*)(ws + WS_YB); bf16* YCAT = (bf16*)(ws + WS_YCAT);

    if (IN(0)) _Pragma("unroll") for (int rep_ = 0; rep_ < NREP(0); ++rep_) { REPBAR(rep_); MKCTX(); phase_prep(p, c); } SEAM(0);
    if (IN(1)) _Pragma("unroll") for (int rep_ = 0; rep_ < NREP(1); ++rep_) { REPBAR(rep_); MKCTX();
        FGemm1 f{(bf16*)(ws + WS_GLU), (bf16*)(ws + WS_GATE), (bf16*)(ws + WS_CQ), (bf16*)(ws + WS_KVRAW)};
        run_gemm(c, XRA, (const bf16*)(ws + WS_WEIN), MP, 2560, 1024, c.cu, f, RS);
#pragma unroll 1
        for (int i = 0; i < 2; ++i) { FMemKV fm{p.out + O_MK + (size_t)i * 2048 * 1024, p.out + O_MV + (size_t)i * 2048 * 1024, (bf16*)(ws + WS_MKV) + (size_t)(2 * i) * 2048 * 1024, (bf16*)(ws + WS_MKV) + (size_t)(2 * i + 1) * 2048 * 1024};
            run_gemm(c, (const bf16*)(ws + WS_MN) + (size_t)i * 2048 * 1024, (const bf16*)(ws + WS_WMKV) + (size_t)i * 2048 * 1024, 2048, 2048, 1024, (c.cu + c.G - c.G / 2 - i * (c.G / 4)) % c.G, fm); }
        skinny_sample(c, XRA, 1024, (const bf16*)(ws + WS_WEIN), 1024, 1024, 2560, f, 0, RS);
    } SEAM(1);
    if (IN(2)) _Pragma("unroll") for (int rep_ = 0; rep_ < NREP(2); ++rep_) { REPBAR(rep_); MKCTX(); phase_conv(p, c); } SEAM(2);
    if (IN(3)) _Pragma("unroll") for (int rep_ = 0; rep_ < NREP(3); ++rep_) { REPBAR(rep_); MKCTX();
        FQ f{(bf16*)(ws + WS_QP), (const float*)(ws + WS_ROPE)};
        run_gemm(c, (const bf16*)(ws + WS_CQN), (const bf16*)(ws + WS_WQ), MP, 1280, 256, c.cu, f);
        skinny_sample(c, (const bf16*)(ws + WS_CQN), 256, (const bf16*)(ws + WS_WQ), 256, 256, 1280, f, 64);
    } SEAM(3);
    if (IN(4)) _Pragma("unroll") for (int rep_ = 0; rep_ < NREP(4); ++rep_) { REPBAR(rep_); MKCTX(); phase_mla(p, c); } SEAM(4);
    if (IN(5)) _Pragma("unroll") for (int rep_ = 0; rep_ < NREP(5); ++rep_) { REPBAR(rep_); MKCTX(); for (int b = c.cu; b < NBS; b += c.G) mla_combine_unit(p, c, b); } SEAM(5);
    if (IN(6)) _Pragma("unroll") for (int rep_ = 0; rep_ < NREP(6); ++rep_) { REPBAR(rep_); MKCTX();
        FPlain f{YB, 1024};
        run_gemm(c, YCAT, (const bf16*)(ws + WS_WEOUT), MP, 1024, 1024, c.cu, f);
        skinny_sample(c, YCAT, 1024, (const bf16*)(ws + WS_WEOUT), 1024, 1024, 1024, f, 0);
    } SEAM(6);
    if (IN(7)) _Pragma("unroll") for (int rep_ = 0; rep_ < NREP(7); ++rep_) { REPBAR(rep_); MKCTX(); phase_resid<false>(p, c, p.in[IN_NQM]); } SEAM(7);
#define CROSS_PHASES(layer, pb) do { \
        if (IN(pb)) _Pragma("unroll") for (int rep_ = 0; rep_ < NREP(pb); ++rep_) { REPBAR(rep_); MKCTX(); FQG f{(bf16*)(ws + WS_XQ), (bf16*)(ws + WS_XG)}; \
            run_gemm(c, XRA, (const bf16*)(ws + WS_WQG) + (size_t)(layer) * 2048 * 1024, MP, 2048, 1024, c.cu, f, RS); \
            skinny_sample(c, XRA, 1024, (const bf16*)(ws + WS_WQG) + (size_t)(layer) * 2048 * 1024, 1024, 1024, 2048, f, 0, RS); } SEAM(pb); \
        if (IN((pb) + 1)) _Pragma("unroll") for (int rep_ = 0; rep_ < NREP((pb) + 1); ++rep_) { REPBAR(rep_); MKCTX(); phase_xattn(p, c, layer); } SEAM((pb) + 1); \
        if (IN((pb) + 2)) _Pragma("unroll") for (int rep_ = 0; rep_ < NREP((pb) + 2); ++rep_) { REPBAR(rep_); MKCTX(); FPlain f{YB, 1024}; \
            run_gemm(c, (const bf16*)(ws + WS_XO), (const bf16*)(ws + WS_WXO) + (size_t)(layer) * 1024 * 1024, MP, 1024, 1024, c.cu, f); \
            skinny_sample(c, (const bf16*)(ws + WS_XO), 1024, (const bf16*)(ws + WS_WXO) + (size_t)(layer) * 1024 * 1024, 1024, 1024, 1024, f, 0); } SEAM((pb) + 2); \
        if (IN((pb) + 3)) _Pragma("unroll") for (int rep_ = 0; rep_ < NREP((pb) + 3); ++rep_) { REPBAR(rep_); MKCTX(); if ((layer) == 0) phase_resid<false>(p, c, p.in[IN_NQX]); else phase_resid<true>(p, c, p.in[IN_NQX] + DM); } SEAM((pb) + 3); \
    } while (0)
    CROSS_PHASES(0, 8);
    if (IN(12)) _Pragma("unroll") for (int rep_ = 0; rep_ < NREP(12); ++rep_) { REPBAR(rep_); MKCTX();
        FOIn f{(bf16*)(ws + WS_ZS), (bf16*)(ws + WS_XBC)};
        run_gemm(c, XRA, (const bf16*)(ws + WS_WOIN), MP, 5120, 1024, c.cu, f, RS);
        skinny_sample(c, XRA, 1024, (const bf16*)(ws + WS_WOIN), 1024, 1024, 5120, f, 0, RS);
        FDt fd{(float*)(ws + WS_DT), p.in[IN_ODTB]};
        for (int u = (c.cu + c.G - 160 % c.G) % c.G; u < MT / 64; u += c.G) { const bf16* Bu = (const bf16*)(ws + WS_WDT); asm volatile("" : "+s"(Bu)); skinny_unit(c, XRA, 1024, Bu, 1024, 1024, 64 * u, 0, 64 * u + 32, 0, fd, RS); }
    } SEAM(12);
    if (IN(13)) _Pragma("unroll") for (int rep_ = 0; rep_ < NREP(13); ++rep_) { REPBAR(rep_); MKCTX(); phase_conv4(p, c); } SEAM(13);
    if (IN(14)) _Pragma("unroll") for (int rep_ = 0; rep_ < NREP(14); ++rep_) { REPBAR(rep_); MKCTX(); phase_ssd(p, c); } SEAM(14);
    if (IN(16)) _Pragma("unroll") for (int rep_ = 0; rep_ < NREP(16); ++rep_) { REPBAR(rep_); MKCTX();
        { pg8::Gemm g{(const bf16*)(ws + WS_YZ), (const bf16*)(ws + WS_WOOUT), MP, 1024, 2048}; pg8::StaticOrder S; S.init(MP, 1024, c.G, c.cu);
          EpiGN E{YB, (const float*)(ws + WS_GS), (PG8_LAS unsigned char*)c.lds, c.G < 256 ? 1 : 0};
          pg8::gemm_phase<EpiGN, pg8::StaticOrder, true, true>((PG8_LAS unsigned char*)c.lds, g, S, E, c.tid); }
        FPlain f{YB, 1024};
        skinny_sample<true>(c, (const bf16*)(ws + WS_YZ), 2048, (const bf16*)(ws + WS_WOOUT), 2048, 2048, 1024, f, 0);
    } SEAM(16);
    if (IN(17)) _Pragma("unroll") for (int rep_ = 0; rep_ < NREP(17); ++rep_) { REPBAR(rep_); MKCTX(); phase_resid<false>(p, c, p.in[IN_NQM] + DM); } SEAM(17);
    CROSS_PHASES(1, 18);
#undef IN
#undef SEAM
}

extern "C" void kernel_launch(void* const* d_in, const int* in_sizes, int n_in, void* d_out, int out_size, void* d_ws, size_t ws_size, hipStream_t stream) {
    static int grid = 0;
    if (grid == 0) {
        if (n_in != 39 || (size_t)out_size != O_END || ws_size < WS_END) { fprintf(stderr, "kernel_launch: unexpected shapes: n_in %d out %d ws %zu (need %zu)\n", n_in, out_size, ws_size, (size_t)WS_END); grid = -1; return; }
        int dev = 0, cus = 0, per_cu = 0;
        if (hipGetDevice(&dev) != hipSuccess || hipDeviceGetAttribute(&cus, hipDeviceAttributeMultiprocessorCount, dev) != hipSuccess) { grid = -1; return; }
        if (hipFuncSetAttribute((const void*)mega_fwd, hipFuncAttributeMaxDynamicSharedMemorySize, LDS_BYTES) != hipSuccess) { fprintf(stderr, "kernel_launch: hipFuncSetAttribute failed\n"); grid = -1; return; }
        if (hipOccupancyMaxActiveBlocksPerMultiprocessor(&per_cu, (const void*)mega_fwd, 512, LDS_BYTES) != hipSuccess || per_cu < 1) { fprintf(stderr, "kernel_launch: occupancy query says %d blocks per CU\n", per_cu); per_cu = 1; }
        (void)hipGetLastError();
        grid = cus;
    }
    if (grid < 0) return;
    (void)hipMemsetAsync((char*)d_ws + WS_CTL + (size_t)CW_BAR * 4, 0, (size_t)XCD_BAR_WORDS * 4, stream);
    Params a{};
    for (int i = 0; i < 39; ++i) a.in[i] = (const float*)d_in[i];
    a.out = (float*)d_out; a.ws = (unsigned char*)d_ws;
#ifndef MK_ONE_LAUNCH
#define MK_ONE_LAUNCH 1
#endif
    if (MK_ONE_LAUNCH) { a.ph_lo = 0; a.ph_hi = NPHASE; hipLaunchKernelGGL(mega_fwd, dim3(grid), dim3(512), LDS_BYTES, stream, a); }
    else for (int ph = 0; ph < NPHASE; ++ph) { a.ph_lo = ph; a.ph_hi = ph + 1; hipLaunchKernelGGL(mega_fwd, dim3(grid), dim3(512), LDS_BYTES, stream, a); }
}
```
